# Optimizing an MI355X kernel written in HIP

```python
import jax, jax.numpy as jnp
from jax import lax
import numpy as np

D_MODEL = 1024
BATCH = 1
SEQ = 16384
DEPTH = 1

CHUNK = 64
D_MIX = D_MODEL
CONV_WIDTH = D_MIX // 2
CONV_GROUPS = 8
CONV_K = 3
SGU_WIDTH = D_MIX - CONV_WIDTH
SGU_GROUPS = 4
SGU_BLOCK = 128
D_IN = 3 * CONV_WIDTH + 2 * SGU_WIDTH
PEER_HEADS = 8
N_KEYS = 128
N_EXPERTS = N_KEYS * N_KEYS
PEER_TOPK = 16
D_QUERY = 256
D_HALF = D_QUERY // 2
PEER_BLOCK = 128
EPS = 1e-6

kernel_name = "hybrid_shortconv_sgu_peer_block"


def rmsnorm(x, g):
    xf = x.astype(jnp.float32)
    xf = xf * lax.rsqrt(jnp.mean(xf * xf, axis=-1, keepdims=True) + EPS)
    return (xf * g.astype(jnp.float32)).astype(x.dtype)


def group_rmsnorm(y, g, groups):
    shp = y.shape
    yf = y.astype(jnp.float32).reshape(shp[:-1] + (groups, shp[-1] // groups))
    yf = yf * lax.rsqrt(jnp.mean(yf * yf, axis=-1, keepdims=True) + EPS)
    return (yf.reshape(shp) * g.astype(jnp.float32)).astype(y.dtype)


def short_conv_mixer(b_gate, c_gate, h, conv_w):
    z = c_gate * h
    seq = z.shape[1]
    zp = jnp.pad(z, ((0, 0), (CONV_K - 1, 0), (0, 0)))
    conv = sum(conv_w[k] * zp[:, k:k + seq] for k in range(CONV_K))
    return b_gate * conv


def spatial_gating_mixer(u, v, w_s, b_s, g_v):
    bsz, seq, _ = u.shape
    nb = seq // SGU_BLOCK
    v = group_rmsnorm(v, g_v, SGU_GROUPS)
    vb = v.reshape(bsz, nb, SGU_BLOCK, SGU_GROUPS, SGU_WIDTH // SGU_GROUPS)
    chunk_id = jnp.arange(SGU_BLOCK) // CHUNK
    mask = chunk_id[:, None] >= chunk_id[None, :]
    w = jnp.where(mask[None], w_s, jnp.zeros((), w_s.dtype))
    mixed = jnp.einsum('gij,bnjgc->bnigc', w, vb) + b_s.T[None, None, :, :, None]
    return u * mixed.reshape(bsz, seq, SGU_WIDTH)


def peer_ffn(x, w_q, sub_keys, expert_u, expert_v):
    bsz, seq, d = x.shape
    xt = x.reshape(-1, PEER_BLOCK, d)

    def block(xb):
        t = xb.shape[0]
        q = (xb @ w_q).reshape(t, PEER_HEADS, 2, D_HALF)
        s = jnp.einsum('thpd,hpkd->thpk', q, sub_keys).astype(jnp.float32)
        v1, i1 = lax.top_k(s[:, :, 0], PEER_TOPK)
        v2, i2 = lax.top_k(s[:, :, 1], PEER_TOPK)
        cand = (v1[..., :, None] + v2[..., None, :]).reshape(t, PEER_HEADS, PEER_TOPK * PEER_TOPK)
        cidx = (i1[..., :, None] * N_KEYS + i2[..., None, :]).reshape(t, PEER_HEADS, PEER_TOPK * PEER_TOPK)
        top, pos = lax.top_k(cand, PEER_TOPK)
        idx = jnp.take_along_axis(cidx, pos, axis=-1)
        gates = jax.nn.softmax(top, axis=-1)
        u_sel = expert_u[idx]
        act = jax.nn.gelu(jnp.einsum('thkd,td->thk', u_sel, xb).astype(jnp.float32), approximate=False)
        v_sel = expert_v[idx]
        return jnp.einsum('thk,thkd->td', (gates * act).astype(xb.dtype), v_sel)

    y = lax.map(block, xt)
    return y.reshape(bsz, seq, d)


def setup_inputs(seed: int = 0) -> dict:
    key = jax.random.key(seed)
    ks = jax.random.split(key, 16)
    f32 = jnp.float32
    L = DEPTH
    nrm = lambda k, shp, s: (jax.random.normal(k, shp, f32) * s).astype(f32)
    return {
        "x": nrm(ks[0], (BATCH, SEQ, D_MODEL), 1.0),
        "attn_norm_g": 1.0 + nrm(ks[1], (L, D_MODEL), 0.02),
        "w_in": nrm(ks[2], (L, D_MODEL, D_IN), D_MODEL ** -0.5),
        "conv_w": nrm(ks[3], (L, CONV_K, CONV_WIDTH), CONV_K ** -0.5),
        "sgu_w": nrm(ks[4], (L, SGU_GROUPS, SGU_BLOCK, SGU_BLOCK), SGU_BLOCK ** -0.5),
        "sgu_b": 1.0 + nrm(ks[5], (L, SGU_GROUPS, SGU_BLOCK), 0.02),
        "sgu_norm_g": 1.0 + nrm(ks[6], (L, SGU_WIDTH), 0.02),
        "out_norm_conv_g": 1.0 + nrm(ks[7], (L, CONV_WIDTH), 0.02),
        "out_norm_sgu_g": 1.0 + nrm(ks[8], (L, SGU_WIDTH), 0.02),
        "w_out": nrm(ks[9], (L, D_MIX, D_MODEL), D_MIX ** -0.5),
        "ffn_norm_g": 1.0 + nrm(ks[10], (L, D_MODEL), 0.02),
        "peer_w_q": nrm(ks[11], (L, D_MODEL, PEER_HEADS * D_QUERY), D_MODEL ** -0.5),
        "peer_sub_keys": nrm(ks[12], (L, PEER_HEADS, 2, N_KEYS, D_HALF), D_HALF ** -0.5),
        "peer_u": nrm(ks[13], (L, N_EXPERTS, D_MODEL), D_MODEL ** -0.5),
        "peer_v": nrm(ks[14], (L, N_EXPERTS, D_MODEL), PEER_HEADS ** -0.5),
        "final_norm_g": 1.0 + nrm(ks[15], (D_MODEL,), 0.02),
    }


def reference(x, attn_norm_g, w_in, conv_w, sgu_w, sgu_b, sgu_norm_g, out_norm_conv_g,
              out_norm_sgu_g, w_out, ffn_norm_g, peer_w_q, peer_sub_keys, peer_u, peer_v,
              final_norm_g):
    h = x
    for l in range(DEPTH):
        xn = rmsnorm(h, attn_norm_g[l])
        proj = xn @ w_in[l]
        c0, c1, c2, c3 = CONV_WIDTH, 2 * CONV_WIDTH, 3 * CONV_WIDTH, 3 * CONV_WIDTH + SGU_WIDTH
        b_gate, c_gate, hc = proj[..., :c0], proj[..., c0:c1], proj[..., c1:c2]
        z = jax.nn.gelu(proj[..., c2:], approximate=False)
        u, v = z[..., :SGU_WIDTH], z[..., SGU_WIDTH:]
        y_conv = short_conv_mixer(b_gate, c_gate, hc, conv_w[l])
        y_sgu = spatial_gating_mixer(u, v, sgu_w[l], sgu_b[l], sgu_norm_g[l])
        y = jnp.concatenate([group_rmsnorm(y_conv, out_norm_conv_g[l], CONV_GROUPS),
                             group_rmsnorm(y_sgu, out_norm_sgu_g[l], SGU_GROUPS)], axis=-1)
        h = h + y @ w_out[l]
        hn = rmsnorm(h, ffn_norm_g[l])
        h = h + peer_ffn(hn, peer_w_q[l], peer_sub_keys[l], peer_u[l], peer_v[l])
    return rmsnorm(h, final_norm_g)
```

```cpp
#include <hip/hip_runtime.h>
#include <cstdio>
#include <cstdint>
#ifndef MK_MODE
#define MK_MODE 2
#endif
namespace pg8 {
#define PG8_LAS __attribute__((address_space(3)))
typedef unsigned short bf16_t;
typedef short bf16x8 __attribute__((ext_vector_type(8)));
typedef float f32x4 __attribute__((ext_vector_type(4)));
typedef unsigned u32x4 __attribute__((ext_vector_type(4)));
constexpr int BM = 256, BK = 64, HALF = 128, HTB = HALF * BK * 2  , STAGE_BYTES = 8 * HTB, NXCD = 8, WGM = 8;

__host__ __device__ __forceinline__ int lds_byte(int r, int c) { const int st = (r >> 4) * 2 + (c >> 5), rr = r & 15, cc = c & 31, ob = rr * 64 + cc * 2; return st * 1024 + (ob ^ (((ob >> 9) & 1) << 5)); }
__host__ __device__ __forceinline__ void stage_rc(int b, int& R, int& C) { const int st = b / 1024, sb = b % 1024, swz = sb ^ (((sb >> 9) & 1) << 5); R = (st >> 1) * 16 + swz / 64; C = (st & 1) * 32 + (swz % 64) / 2; }
__host__ __device__ __forceinline__ int perm32(int rho) { const int n = rho >> 4, i = rho & 15; return 8 * (i >> 2) + 4 * n + (i & 3); }

struct Unit { int pm, pn; };
struct Gemm { const bf16_t* A; const bf16_t* Bt; int M, N, K; };

struct StaticOrder {
    int nM, nN, nwg, G, c;
    __host__ __device__ void init(int M, int N, int G_, int c_) { nM = M / BM; nN = N / BM; nwg = nM * nN; G = G_; c = c_; }
    __host__ __device__ bool next(int i, Unit& u) const {
        const long L = (long)i * G + c; if (L >= nwg) return false;
        int wgid = (int)L; { const int q = nwg / NXCD, r = nwg % NXCD, xcd = wgid % NXCD, off = wgid / NXCD; wgid = (xcd < r ? xcd * (q + 1) : r * (q + 1) + (xcd - r) * q) + off; }
        const int nig = WGM * nN, gid = wgid / nig, fm = gid * WGM, gsz = (nM - fm) < WGM ? (nM - fm) : WGM;
        u.pm = fm + ((wgid % nig) % gsz); u.pn = (wgid % nig) / gsz; return true;
    }
    __device__ __forceinline__ void a_ready(const Unit&) const {}
    __device__ __forceinline__ void done(const Unit&) const {}
};

__device__ __forceinline__ unsigned cvt_pk_bf16(float lo, float hi) { unsigned r; asm volatile("v_cvt_pk_bf16_f32 %0, %1, %2" : "=v"(r) : "v"(lo), "v"(hi)); return r; }
typedef float f32x2 __attribute__((ext_vector_type(2)));
__device__ __forceinline__ f32x2 gelu_pk(f32x2 v) {
    const f32x2 av = __builtin_elementwise_abs(v), d = av * 0.2316418882f + 1.0f;
    f32x2 t; t.x = __builtin_amdgcn_rcpf(d.x); t.y = __builtin_amdgcn_rcpf(d.y);
    f32x2 q = t * 0.5307027145f + (-0.7265760135f); q = q * t + 0.7107068705f; q = q * t + (-0.142248368f); q = q * t + 0.127414796f; q = q * t;
    const f32x2 s = (v * v) * (-0.72134752044f);
    f32x2 e; e.x = __builtin_amdgcn_exp2f(s.x); e.y = __builtin_amdgcn_exp2f(s.y);
    const f32x2 m = v * (q * e), r = v - m;
    f32x2 o; o.x = v.x < 0.f ? m.x : r.x; o.y = v.y < 0.f ? m.y : r.y; return o;
}


struct EpiProj {
    static constexpr bool PERM = true, AFTER_DRAIN = false;
    bf16_t* O; int ldc; int gelu_from_pn;
    __device__ __forceinline__ void operator()(const f32x4 (&acc)[2][2][4][2], const Unit& u, int wr, int wc, int fr, int fq) const {
        const int row0 = u.pm * BM + wr * 64 + fr; const int col0 = u.pn * BM + wc * 32 + 8 * fq;
        const bool act = u.pn >= gelu_from_pn;
#pragma unroll
        for (int ai = 0; ai < 2; ++ai)
#pragma unroll
            for (int m = 0; m < 4; ++m) { bf16_t* rowp = O + (size_t)(row0 + ai * HALF + m * 16) * ldc + col0;
#pragma unroll
                for (int bj = 0; bj < 2; ++bj) { f32x4 v0 = acc[ai][bj][m][0], v1 = acc[ai][bj][m][1];
                    if (act) { f32x2 a = gelu_pk((f32x2){v0[0], v0[1]}), b = gelu_pk((f32x2){v0[2], v0[3]}), c = gelu_pk((f32x2){v1[0], v1[1]}), d = gelu_pk((f32x2){v1[2], v1[3]});
                        v0 = (f32x4){a.x, a.y, b.x, b.y}; v1 = (f32x4){c.x, c.y, d.x, d.y}; }
                    u32x4 w; w.x = cvt_pk_bf16(v0[0], v0[1]); w.y = cvt_pk_bf16(v0[2], v0[3]); w.z = cvt_pk_bf16(v1[0], v1[1]); w.w = cvt_pk_bf16(v1[2], v1[3]);
                    *(u32x4*)(rowp + bj * HALF) = w; } }
    }
};
struct EpiH {
    static constexpr bool PERM = false, AFTER_DRAIN = false;
    const float* X; bf16_t* HB; float* sumsq; int ldc;
    __device__ __forceinline__ void operator()(const f32x4 (&acc)[2][2][4][2], const Unit& u, int wr, int wc, int fr, int fq) const {
        const int col0 = u.pn * BM + wc * 32 + 4 * fq;
        f32x4 xa[4][2][2];
#pragma unroll
        for (int m = 0; m < 4; ++m) { const size_t off = (size_t)(u.pm * BM + wr * 64 + m * 16 + fr) * ldc + col0;
#pragma unroll
            for (int bj = 0; bj < 2; ++bj)
#pragma unroll
                for (int n = 0; n < 2; ++n) xa[m][bj][n] = *(const f32x4*)(X + off + bj * HALF + n * 16); }
#pragma unroll
        for (int ai = 0; ai < 2; ++ai)
#pragma unroll
            for (int m = 0; m < 4; ++m) { const int r = u.pm * BM + ai * HALF + wr * 64 + m * 16 + fr; const size_t off = (size_t)r * ldc + col0; float ss = 0.f;
                f32x4 h[2][2];
#pragma unroll
                for (int bj = 0; bj < 2; ++bj)
#pragma unroll
                    for (int n = 0; n < 2; ++n) h[bj][n] = xa[m][bj][n] + acc[ai][bj][m][n];
                if (ai == 0) {
#pragma unroll
                    for (int bj = 0; bj < 2; ++bj)
#pragma unroll
                        for (int n = 0; n < 2; ++n) xa[m][bj][n] = *(const f32x4*)(X + off + (size_t)HALF * ldc + bj * HALF + n * 16); }
#pragma unroll
                for (int bj = 0; bj < 2; ++bj)
#pragma unroll
                    for (int n = 0; n < 2; ++n) { const f32x4 hv = h[bj][n];
                        ss += (hv[0] * hv[0] + hv[1] * hv[1]) + (hv[2] * hv[2] + hv[3] * hv[3]);
                        unsigned w0 = cvt_pk_bf16(hv[0], hv[1]), w1 = cvt_pk_bf16(hv[2], hv[3]);
                        typedef unsigned u32x2 __attribute__((ext_vector_type(2))); *(u32x2*)(HB + off + bj * HALF + n * 16) = (u32x2){w0, w1}; }
                ss += __shfl_xor(ss, 16); ss += __shfl_xor(ss, 32);
                if (fq == 0) atomicAdd(sumsq + r, ss); }
    }
};
struct EpiQ {
    static constexpr bool PERM = true, AFTER_DRAIN = false;
    bf16_t* O; int ldc; const float* sumsq; float inv_d, eps;
    __device__ __forceinline__ void operator()(const f32x4 (&acc)[2][2][4][2], const Unit& u, int wr, int wc, int fr, int fq) const {
        const int row0 = u.pm * BM + wr * 64 + fr; const int col0 = u.pn * BM + wc * 32 + 8 * fq;
#pragma unroll
        for (int ai = 0; ai < 2; ++ai)
#pragma unroll
            for (int m = 0; m < 4; ++m) { const int r = row0 + ai * HALF + m * 16; bf16_t* rowp = O + (size_t)r * ldc + col0;
                const float sc = __builtin_amdgcn_rsqf(sumsq[r] * inv_d + eps);
#pragma unroll
                for (int bj = 0; bj < 2; ++bj) { const f32x4 v0 = acc[ai][bj][m][0] * sc, v1 = acc[ai][bj][m][1] * sc;
                    u32x4 w; w.x = cvt_pk_bf16(v0[0], v0[1]); w.y = cvt_pk_bf16(v0[2], v0[3]); w.z = cvt_pk_bf16(v1[0], v1[1]); w.w = cvt_pk_bf16(v1[2], v1[3]);
                    *(u32x4*)(rowp + bj * HALF) = w; } }
    }
};
template <class Epi, class Sched, bool ALIGN_EPI = false, bool SP2 = false>
__device__ __forceinline__ void gemm_phase(PG8_LAS unsigned char* lds, const Gemm g, const Sched& S, const Epi& E) {
    const int tid = threadIdx.x, wid = __builtin_amdgcn_readfirstlane(tid >> 6), lane = tid & 63, wr = wid >> 2, wc = wid & 3, fr = lane & 15, fq = lane >> 4;
    const int K = g.K, nt = K / BK;
    unsigned voffA[2], voffB[2];
#pragma unroll
    for (int i = 0; i < 2; ++i) { int R, C; stage_rc(tid * 16 + i * 8192, R, C); const int Rb = Epi::PERM ? ((R & ~31) + perm32(R & 31)) : R;
        voffA[i] = (unsigned)(R * K + C) * 2u; voffB[i] = (unsigned)(Rb * K + C) * 2u; }
    const size_t kstep = (size_t)(BK * 2);
    const size_t hstep = (size_t)HALF * K * 2;
    const size_t tstep = 2 * hstep;
    const unsigned ldsw = (unsigned)wid * 1024u;
    const int aoff = lds_byte(wr * 64 + fr, fq * 8), boff = lds_byte(wc * 32 + fr, fq * 8);
#define PG8_SA(b, h) (((b) * 2 + (h)) * HTB)
#define PG8_SB(b, h) ((4 + (b) * 2 + (h)) * HTB)
#define PG8_STAGE(bufoff, gbase, voff) do { _Pragma("unroll") for (int _i = 0; _i < 2; ++_i) \
        __builtin_amdgcn_global_load_lds((const unsigned*)((const char*)(gbase) + (voff)[_i]), (PG8_LAS unsigned*)(lds + (bufoff) + ldsw + _i * 8192), 16, 0, 0); } while (0)
#define PG8_LDA(dst, b, h) do { _Pragma("unroll") for (int m = 0; m < 4; ++m) _Pragma("unroll") for (int k = 0; k < 2; ++k) dst[m][k] = *(const PG8_LAS bf16x8*)(lds + PG8_SA(b, h) + aoff + m * 2048 + k * 1024); } while (0)
#define PG8_LDB(dst, b, h) do { _Pragma("unroll") for (int n = 0; n < 2; ++n) _Pragma("unroll") for (int k = 0; k < 2; ++k) dst[n][k] = *(const PG8_LAS bf16x8*)(lds + PG8_SB(b, h) + boff + n * 2048 + k * 1024); } while (0)
#define PG8_MMA(ai, bj, At, Bt) do { __builtin_amdgcn_s_setprio(1); _Pragma("unroll") for (int m = 0; m < 4; ++m) _Pragma("unroll") for (int n = 0; n < 2; ++n) _Pragma("unroll") for (int k = 0; k < 2; ++k) \
        acc[ai][bj][m][n] = __builtin_amdgcn_mfma_f32_16x16x32_bf16(Bt[n][k], At[m][k], acc[ai][bj][m][n], 0, 0, 0); __builtin_amdgcn_s_setprio(0); } while (0)
#define PG8_WAIT_V(n) asm volatile("s_waitcnt vmcnt(" #n ")" ::: "memory")
#define PG8_WAIT_L(n) asm volatile("s_waitcnt lgkmcnt(" #n ")" ::: "memory")
#define PG8_BAR __builtin_amdgcn_s_barrier()
#define PG8_SCHED __builtin_amdgcn_sched_barrier(0)
    Unit cur, nxt; int ui = 0;
    if (!S.next(0, cur)) return;
    f32x4 acc[2][2][4][2];
#pragma unroll
    for (int a = 0; a < 2; ++a)
#pragma unroll
        for (int b = 0; b < 2; ++b)
#pragma unroll
            for (int m = 0; m < 4; ++m)
#pragma unroll
                for (int n = 0; n < 2; ++n) acc[a][b][m][n] = (f32x4){0.f, 0.f, 0.f, 0.f};
    bf16x8 At[4][2], B0[2][2], B1[2][2];
    const char* cA = (const char*)g.A + (size_t)cur.pm * tstep; const char* cB = (const char*)g.Bt + (size_t)cur.pn * tstep;
    S.a_ready(cur);
    if constexpr (SP2) {
        PG8_STAGE(PG8_SB(0, 0), cB, voffB); PG8_STAGE(PG8_SB(0, 1), cB + hstep, voffB); PG8_STAGE(PG8_SA(0, 0), cA, voffA); PG8_STAGE(PG8_SA(0, 1), cA + hstep, voffA);
        if (wr == 1) PG8_BAR;
        PG8_WAIT_V(2); PG8_BAR;
        PG8_STAGE(PG8_SB(1, 0), cB + kstep, voffB); PG8_STAGE(PG8_SA(1, 0), cA + kstep, voffA); PG8_STAGE(PG8_SB(1, 1), cB + hstep + kstep, voffB);
        PG8_WAIT_V(6); PG8_BAR;
    } else {
        PG8_STAGE(PG8_SB(0, 0), cB, voffB); PG8_STAGE(PG8_SA(0, 0), cA, voffA); PG8_STAGE(PG8_SB(0, 1), cB + hstep, voffB); PG8_STAGE(PG8_SA(0, 1), cA + hstep, voffA);
        if (wr == 1) PG8_BAR;
        PG8_WAIT_V(4); PG8_BAR;
        PG8_STAGE(PG8_SB(1, 0), cB + kstep, voffB); PG8_STAGE(PG8_SA(1, 0), cA + kstep, voffA); PG8_STAGE(PG8_SB(1, 1), cB + hstep + kstep, voffB);
        PG8_WAIT_V(6); PG8_BAR;
    }
    for (;;) {
        const bool has_next = S.next(ui + 1, nxt);
        const char* nA = has_next ? (const char*)g.A + (size_t)nxt.pm * tstep : cA; const char* nB = has_next ? (const char*)g.Bt + (size_t)nxt.pn * tstep : cB;
        for (int t = 0; t < nt; t += 2) {
            const bool last = (t == nt - 2);
            const char* a1 = cA + (size_t)(t + 1) * kstep;
            const char* a2 = last ? nA : cA + (size_t)(t + 2) * kstep; const char* b2 = last ? nB : cB + (size_t)(t + 2) * kstep;
            const char* a3 = a2 + kstep; const char* b3 = b2 + kstep;
            if (last && has_next) S.a_ready(nxt);
            if constexpr (SP2) {
            PG8_LDB(B0, 0, 0); PG8_LDB(B1, 0, 1); PG8_SCHED; PG8_LDA(At, 0, 0); PG8_STAGE(PG8_SA(1, 1), a1 + hstep, voffA);
            PG8_WAIT_V(8); PG8_WAIT_L(0); PG8_BAR; PG8_MMA(0, 0, At, B0); PG8_MMA(0, 1, At, B1); PG8_BAR; PG8_SCHED;
            PG8_LDA(At, 0, 1); PG8_STAGE(PG8_SB(0, 0), b2, voffB); PG8_STAGE(PG8_SB(0, 1), b2 + hstep, voffB); PG8_STAGE(PG8_SA(0, 0), a2, voffA);
            PG8_WAIT_V(8); PG8_WAIT_L(0); PG8_BAR; PG8_MMA(1, 0, At, B0); PG8_MMA(1, 1, At, B1); PG8_BAR; PG8_SCHED;
            PG8_LDB(B0, 1, 0); PG8_LDB(B1, 1, 1); PG8_SCHED; PG8_LDA(At, 1, 0); PG8_STAGE(PG8_SA(0, 1), a2 + hstep, voffA);
            PG8_WAIT_V(8); PG8_WAIT_L(0); PG8_BAR; PG8_MMA(0, 0, At, B0); PG8_MMA(0, 1, At, B1); PG8_BAR; PG8_SCHED;
            PG8_LDA(At, 1, 1); PG8_STAGE(PG8_SB(1, 0), b3, voffB); PG8_STAGE(PG8_SB(1, 1), b3 + hstep, voffB); PG8_STAGE(PG8_SA(1, 0), a3, voffA);
            PG8_WAIT_V(8); PG8_WAIT_L(0); PG8_BAR; PG8_MMA(1, 0, At, B0); PG8_MMA(1, 1, At, B1); PG8_BAR; PG8_SCHED;
            } else {
            PG8_LDB(B0, 0, 0); PG8_SCHED; PG8_LDA(At, 0, 0); PG8_STAGE(PG8_SA(1, 1), a1 + hstep, voffA);
            PG8_WAIT_L(8); PG8_BAR; PG8_WAIT_L(0); PG8_MMA(0, 0, At, B0); PG8_BAR; PG8_SCHED;
            PG8_LDB(B1, 0, 1); PG8_STAGE(PG8_SB(0, 0), b2, voffB);
            PG8_BAR; PG8_WAIT_L(0); PG8_MMA(0, 1, At, B1); PG8_BAR;
            PG8_LDA(At, 0, 1); PG8_STAGE(PG8_SA(0, 0), a2, voffA);
            PG8_BAR; PG8_WAIT_L(0); PG8_MMA(1, 0, At, B0); PG8_BAR; PG8_SCHED;
            PG8_STAGE(PG8_SB(0, 1), b2 + hstep, voffB);
            PG8_WAIT_V(6); PG8_BAR; PG8_MMA(1, 1, At, B1); PG8_BAR;
            PG8_LDB(B0, 1, 0); PG8_SCHED; PG8_LDA(At, 1, 0); PG8_STAGE(PG8_SA(0, 1), a2 + hstep, voffA);
            PG8_WAIT_L(8); PG8_BAR; PG8_WAIT_L(0); PG8_MMA(0, 0, At, B0); PG8_BAR; PG8_SCHED;
            PG8_LDB(B1, 1, 1); PG8_STAGE(PG8_SB(1, 0), b3, voffB);
            PG8_BAR; PG8_WAIT_L(0); PG8_MMA(0, 1, At, B1); PG8_BAR;
            PG8_LDA(At, 1, 1); PG8_STAGE(PG8_SA(1, 0), a3, voffA);
            PG8_BAR; PG8_WAIT_L(0); PG8_MMA(1, 0, At, B0); PG8_BAR; PG8_SCHED;
            PG8_STAGE(PG8_SB(1, 1), b3 + hstep, voffB);
            PG8_WAIT_V(6); PG8_BAR; PG8_MMA(1, 1, At, B1); PG8_BAR;
            }
        }
        if constexpr (ALIGN_EPI) { if (wr == 0) PG8_BAR; }
        if constexpr (!Epi::AFTER_DRAIN) { E(acc, cur, wr, wc, fr, fq); S.done(cur); }
        if (!has_next) break;
#pragma unroll
        for (int a = 0; a < 2; ++a)
#pragma unroll
            for (int b = 0; b < 2; ++b)
#pragma unroll
                for (int m = 0; m < 4; ++m)
#pragma unroll
                    for (int n = 0; n < 2; ++n) acc[a][b][m][n] = (f32x4){0.f, 0.f, 0.f, 0.f};
        cur = nxt; cA = nA; cB = nB; ++ui;
        if constexpr (ALIGN_EPI) { if (wr == 1) PG8_BAR; }
    }
    PG8_WAIT_V(0);
    if constexpr (!ALIGN_EPI) { if (wr == 0) PG8_BAR; }
    PG8_BAR;
    if constexpr (Epi::AFTER_DRAIN) { E.fused(acc, cur, wr, wc, fr, fq, lds, wid, lane); S.done(cur); }
#undef PG8_SA
#undef PG8_SB
#undef PG8_STAGE
#undef PG8_LDA
#undef PG8_LDB
#undef PG8_MMA
#undef PG8_WAIT_V
#undef PG8_WAIT_L
#undef PG8_BAR
#undef PG8_SCHED
}
}

constexpr int NWAVES = 8;
constexpr int M = 16384, D = 1024, DIN = 2560, CW = 512, SW = 512, NQ = 2048, NEXP = 16384, NH = 8, TOPK = 16, NSEL = NH * TOPK;
constexpr int C_B = 0, C_C = 512, C_H = 1024, C_U = 1536, C_V = 2048;
constexpr float EPS = 1e-6f;
constexpr size_t MiB = 1u << 20;
constexpr size_t WS_CTL = 0, CTL_ZERO_BYTES = 128 * 1024;
constexpr size_t WS_WIN = 1 * MiB, WS_WOUT = 6 * MiB, WS_WQ = 8 * MiB, WS_KEYS = 12 * MiB, WS_SGUW = 12 * MiB + 512 * 1024;
constexpr size_t WS_U8 = 16 * MiB, WS_V8 = 32 * MiB, WS_SU = 48 * MiB, WS_SV = 48 * MiB + 65536;
constexpr size_t WS_XN = 80 * MiB, WS_Y = 80 * MiB;
constexpr size_t WS_PROJ = 112 * MiB, WS_Q = 112 * MiB;
constexpr size_t WS_HB = 192 * MiB, WS_IDX = 224 * MiB, WS_GATE = 232 * MiB, WS_END = 240 * MiB;
constexpr int CW_BAR = 4096;
constexpr int CW_SUMSQ = 8192;
static_assert(WS_V8 == WS_U8 + (size_t)NEXP * D && WS_SV == WS_SU + (size_t)NEXP * 4, "table map");
static_assert(CW_BAR + 3456 <= CW_SUMSQ && (CW_SUMSQ + M) * 4 <= (int)CTL_ZERO_BYTES, "ctl");
constexpr int RING_BYTES = 131072, LDSCTL_OFF = RING_BYTES, MISC_OFF = LDSCTL_OFF + 320, LDS_BYTES = 147456;

#define GAS __attribute__((address_space(1)))
#define LAS __attribute__((address_space(3)))
typedef unsigned short bf16;
typedef unsigned v4u __attribute__((ext_vector_type(4)));
typedef unsigned v2u __attribute__((ext_vector_type(2)));
typedef float f32x4 __attribute__((ext_vector_type(4)));
typedef float f32x16 __attribute__((ext_vector_type(16)));
typedef short bf16x8 __attribute__((ext_vector_type(8)));
typedef __bf16 bf16x2v __attribute__((ext_vector_type(2)));
typedef float f32x2 __attribute__((ext_vector_type(2)));
typedef GAS unsigned gu32;
#define RLX_AGENT __ATOMIC_RELAXED, __HIP_MEMORY_SCOPE_AGENT
#define LDS_WAIT() asm volatile("s_waitcnt lgkmcnt(0)" ::: "memory")
#define VM_WAIT() asm volatile("s_waitcnt vmcnt(0)" ::: "memory")
__device__ __forceinline__ unsigned f2bf(float f) { unsigned u = __builtin_bit_cast(unsigned, f); return (u + 0x7fffu + ((u >> 16) & 1u)) >> 16; }
__device__ __forceinline__ unsigned pk2(float lo, float hi) { return f2bf(lo) | (f2bf(hi) << 16); }
__device__ __forceinline__ float bflo(unsigned w) { return __builtin_bit_cast(float, w << 16); }
__device__ __forceinline__ float bfhi(unsigned w) { return __builtin_bit_cast(float, w & 0xffff0000u); }
__device__ __forceinline__ float bf2f(bf16 b) { return __builtin_bit_cast(float, (unsigned)b << 16); }
__device__ __forceinline__ float wave_sum(float v) {
#pragma unroll
    for (int o = 1; o < 64; o <<= 1) v += __shfl_xor(v, o);
    return v;
}
__device__ __forceinline__ float gelu_exact(float v) { return 0.5f * v * (1.0f + erff(v * 0.70710678118654752f)); }
#define XB_TMO      128
#define XB_XCNT(j)  (256  + 64 * (j))
#define XB_XSUB(j)  (1280 + 64 * (j))
#define XB_XGEN(j)  (2304 + 64 * (j))
#define XB_TOP      3328
#define XB_TOPGEN   3392
#define XCD_BAR_WORDS 3456
#define XB_SPIN_CAP (1u << 18)

__device__ __forceinline__ unsigned xb_ld(unsigned* p)              { return __hip_atomic_load(p, __ATOMIC_RELAXED, __HIP_MEMORY_SCOPE_AGENT); }
__device__ __forceinline__ unsigned xb_add(unsigned* p, unsigned v) { return __hip_atomic_fetch_add(p, v, __ATOMIC_RELAXED, __HIP_MEMORY_SCOPE_AGENT); }
__device__ __forceinline__ unsigned xb_xcc_id() { return (unsigned)__builtin_amdgcn_s_getreg((3 << 11) | 20) & 0xFu; }
#define XB_SPIN(cond, bar) do { unsigned _sp = 0; while (cond) { __builtin_amdgcn_s_sleep(1); \
    if ((++_sp & 255u) == 0u) { if (xb_ld(&(bar)[XB_TMO])) break; if (_sp > XB_SPIN_CAP) { atomicAdd(&(bar)[XB_TMO], 1u); break; } } } } while (0)

struct XcdBarrier {
    unsigned* bar; unsigned x;
    volatile LAS unsigned* st;
};

__device__ __forceinline__ XcdBarrier xcd_barrier_post(unsigned* bar, volatile LAS unsigned* st) {
    XcdBarrier b; b.bar = bar; b.x = xb_xcc_id(); b.st = st;
    if (threadIdx.x == 0) (void)xb_add(&bar[XB_XCNT(b.x)], 1u);
    return b;
}
__device__ __forceinline__ void xcd_barrier_complete(unsigned* bar, unsigned x, unsigned& nloc, unsigned& nx) {
    const unsigned G = gridDim.x * gridDim.y * gridDim.z;
    unsigned sum, cnt, mine, sp = 0u;
    for (;;) {
        sum = 0u; cnt = 0u; mine = 0u;
#pragma unroll
        for (unsigned j = 0; j < 16; ++j) { const unsigned c = xb_ld(&bar[XB_XCNT(j)]); sum += c; cnt += (c > 0u) ? 1u : 0u; mine = (j == x) ? c : mine; }
        if (sum == G) break;
        __builtin_amdgcn_s_sleep(1);
        if ((++sp & 255u) == 0u) { if (xb_ld(&bar[XB_TMO])) break; if (sp > XB_SPIN_CAP) { atomicAdd(&bar[XB_TMO], 1u); break; } }
    }
    nloc = mine > 0u ? mine : 1u; nx = cnt > 0u ? cnt : 1u;
}

__device__ __forceinline__ void xcd_barrier(const XcdBarrier& b) {
    asm volatile("s_waitcnt vmcnt(0)" ::: "memory");
    __syncthreads();
    if (threadIdx.x == 0) {
        unsigned* bar = b.bar;
        __builtin_amdgcn_s_waitcnt(0);
        unsigned nloc = b.st[0], nx = b.st[1];
        if (nloc == 0u) { xcd_barrier_complete(bar, b.x, nloc, nx); b.st[0] = nloc; b.st[1] = nx; }
        const unsigned old = xb_add(&bar[XB_XSUB(b.x)], 1u);
        const unsigned gen = old / nloc;
        if (old + 1u == (gen + 1u) * nloc) {
            __builtin_amdgcn_fence(__ATOMIC_RELEASE, "agent");
            asm volatile("s_waitcnt vmcnt(0)" ::: "memory");
            const unsigned og = xb_add(&bar[XB_TOP], 1u);
            const unsigned tg = og / nx;
            if (og + 1u == (tg + 1u) * nx) xb_add(&bar[XB_TOPGEN], 1u);
            else XB_SPIN(xb_ld(&bar[XB_TOPGEN]) == tg, bar);
            __builtin_amdgcn_fence(__ATOMIC_ACQUIRE, "agent");
            xb_add(&bar[XB_XGEN(b.x)], 1u);
            asm volatile("s_waitcnt vmcnt(0)" ::: "memory");
        } else {
            XB_SPIN(xb_ld(&bar[XB_XGEN(b.x)]) == gen, bar);
            __builtin_amdgcn_fence(__ATOMIC_ACQUIRE, "agent");
            asm volatile("s_waitcnt vmcnt(0)" ::: "memory");
        }
    }
    __syncthreads();
}

struct Frame {
    LAS unsigned char* lds;
    volatile LAS unsigned* MISC;
    gu32* ctl;
    int tid, lane, wave, vcu, G, gw, NGW;
    const float *x, *attn_g, *w_in, *conv_w, *sgu_w, *sgu_b, *sgu_norm_g, *onc_g, *ons_g, *w_out, *ffn_g, *w_q, *sub_keys, *peer_u, *peer_v, *final_g;
    float* out;
    bf16 *WinT, *WoutT, *WqT, *KEYS, *SGUW, *XN, *Y, *PROJ, *Q, *HB;
    unsigned char *U8, *V8; float *SU, *SV;
    int* IDX; float* GATE; float* sumsq;
};
__device__ __forceinline__ void frame_ptrs(Frame& F, const float* const* in, float* out, unsigned char* ws) {
    F.x = in[0]; F.attn_g = in[1]; F.w_in = in[2]; F.conv_w = in[3]; F.sgu_w = in[4]; F.sgu_b = in[5]; F.sgu_norm_g = in[6]; F.onc_g = in[7]; F.ons_g = in[8];
    F.w_out = in[9]; F.ffn_g = in[10]; F.w_q = in[11]; F.sub_keys = in[12]; F.peer_u = in[13]; F.peer_v = in[14]; F.final_g = in[15]; F.out = out;
    F.ctl = (gu32*)(ws + WS_CTL);
    F.WinT = (bf16*)(ws + WS_WIN); F.WoutT = (bf16*)(ws + WS_WOUT); F.WqT = (bf16*)(ws + WS_WQ); F.KEYS = (bf16*)(ws + WS_KEYS); F.SGUW = (bf16*)(ws + WS_SGUW);
    F.U8 = ws + WS_U8; F.V8 = ws + WS_V8; F.SU = (float*)(ws + WS_SU); F.SV = (float*)(ws + WS_SV); F.XN = (bf16*)(ws + WS_XN); F.Y = (bf16*)(ws + WS_Y); F.PROJ = (bf16*)(ws + WS_PROJ); F.Q = (bf16*)(ws + WS_Q);
    F.HB = (bf16*)(ws + WS_HB); F.IDX = (int*)(ws + WS_IDX); F.GATE = (float*)(ws + WS_GATE); F.sumsq = (float*)(ws + WS_CTL) + CW_SUMSQ;
}

__device__ __forceinline__ void p0_transpose_item(const float* W, int K, int N, bf16* WT, LAS float* scr, int item, int lane, const float* rowscale = nullptr) {
    const int nblk = N / 32, kb = item / nblk, nb = item % nblk, k0 = 64 * kb, n0 = 32 * nb;
#pragma unroll 8
    for (int i = 0; i < 32; ++i) { const int kk = 2 * i + (lane >> 5); scr[kk * 33 + (lane & 31)] = W[(size_t)(k0 + kk) * N + n0 + (lane & 31)] * (rowscale ? rowscale[k0 + kk] : 1.0f); }
    LDS_WAIT(); asm volatile("" ::: "memory");
    const int c = lane & 7;
#pragma unroll
    for (int j = 0; j < 4; ++j) { const int n = (lane >> 3) + 8 * j; const LAS float* s = scr + (8 * c) * 33 + n;
        v4u o; o.x = pk2(s[0 * 33], s[1 * 33]); o.y = pk2(s[2 * 33], s[3 * 33]); o.z = pk2(s[4 * 33], s[5 * 33]); o.w = pk2(s[6 * 33], s[7 * 33]);
        *(v4u*)(WT + (size_t)(n0 + n) * K + k0 + 8 * c) = o; }
    LDS_WAIT(); asm volatile("" ::: "memory");
}
__device__ __forceinline__ v4u cvt8(const float* p) { const f32x4 a = *(const f32x4*)p, b = *(const f32x4*)(p + 4); v4u o; o.x = pk2(a[0], a[1]); o.y = pk2(a[2], a[3]); o.z = pk2(b[0], b[1]); o.w = pk2(b[2], b[3]); return o; }
__device__ __forceinline__ unsigned pack_i8(float a, float b, float c, float d) {
    const int ia = (int)rintf(a), ib = (int)rintf(b), ic = (int)rintf(c), id = (int)rintf(d);
    return ((unsigned)ia & 0xffu) | (((unsigned)ib & 0xffu) << 8) | (((unsigned)ic & 0xffu) << 16) | ((unsigned)id << 24);
}
__device__ __forceinline__ void convert_tables(Frame& F, int cw, int ncw, int row_lo, int row_hi) {
    const int lane = F.lane;
    constexpr int RB = 4;
    for (int r0 = row_lo + cw * RB; r0 < row_hi; r0 += ncw * RB) {
        f32x4 v[RB][4];
#pragma unroll
        for (int q = 0; q < RB; ++q) { const int rrow = r0 + q; const bool second = rrow >= NEXP; const int e = second ? rrow - NEXP : rrow;
            const f32x4* src = (const f32x4*)((second ? F.peer_v : F.peer_u) + (size_t)e * D) + lane;
#pragma unroll
            for (int j = 0; j < 4; ++j) v[q][j] = src[64 * j]; }
#pragma unroll
        for (int q = 0; q < RB; ++q) { const int rrow = r0 + q; const bool second = rrow >= NEXP; const int e = second ? rrow - NEXP : rrow;
            float mx = 0.f;
#pragma unroll
            for (int j = 0; j < 4; ++j) mx = fmaxf(fmaxf(mx, fmaxf(fabsf(v[q][j][0]), fabsf(v[q][j][1]))), fmaxf(fabsf(v[q][j][2]), fabsf(v[q][j][3])));
#pragma unroll
            for (int o = 1; o < 64; o <<= 1) mx = fmaxf(mx, __shfl_xor(mx, o));
            const float top = second ? 440.f : 127.f;
            const float sc = mx > 0.f ? top / mx : 1.f, inv = mx > 0.f ? mx / top : 1.f;
            unsigned* dst = (unsigned*)(F.U8 + (size_t)rrow * D) + lane;
            if (second) {
#pragma unroll
                for (int j = 0; j < 4; ++j) { int w = 0; w = __builtin_amdgcn_cvt_pk_fp8_f32(v[q][j][0] * sc, v[q][j][1] * sc, w, false); w = __builtin_amdgcn_cvt_pk_fp8_f32(v[q][j][2] * sc, v[q][j][3] * sc, w, true); dst[64 * j] = (unsigned)w; }
            } else {
#pragma unroll
                for (int j = 0; j < 4; ++j) dst[64 * j] = pack_i8(v[q][j][0] * sc, v[q][j][1] * sc, v[q][j][2] * sc, v[q][j][3] * sc);
            }
            if (lane == 0) F.SU[rrow] = inv;
        }
    }
}

__device__ __forceinline__ void late_weights(Frame& F, int cw, int ncw) {
    LAS float* scr = (LAS float*)(F.lds + F.wave * 16384);
    const int lane = F.lane;
    constexpr int I_OUT = (D / 64) * (D / 32), I_Q = (D / 64) * (NQ / 32);
    for (int it = cw; it < I_OUT + I_Q; it += ncw) {
        if (it < I_OUT) p0_transpose_item(F.w_out, D, D, F.WoutT, scr, it, lane);
        else p0_transpose_item(F.w_q, D, NQ, F.WqT, scr, it - I_OUT, lane, F.ffn_g);
    }
    for (int i = cw * 64 + lane; i < 262144 / 8; i += ncw * 64) *(v4u*)(F.KEYS + (size_t)i * 8) = cvt8(F.sub_keys + (size_t)i * 8);
}
__device__ __forceinline__ void p0_prologue(Frame& F) {
    LAS float* scr = (LAS float*)(F.lds + F.wave * 16384);
    const int gw = F.gw, NGW = F.NGW, lane = F.lane;
    constexpr int I_IN = (D / 64) * (DIN / 32);
    for (int it = gw; it < I_IN; it += NGW) p0_transpose_item(F.w_in, D, DIN, F.WinT, scr, it, lane);
    for (int i = gw * 64 + lane; i < 65536 / 8; i += NGW * 64) {
        const int e = i * 8, ii = (e >> 7) & 127, jj = e & 127; v4u o = cvt8(F.sgu_w + e); if ((ii >> 6) < (jj >> 6)) o = (v4u){0u, 0u, 0u, 0u}; *(v4u*)(F.SGUW + e) = o;
    }
    for (int m0 = gw * 4; m0 < M; m0 += NGW * 4) {
        f32x4 v[4][4];
#pragma unroll
        for (int q = 0; q < 4; ++q) { const f32x4* xr = (const f32x4*)(F.x + (size_t)(m0 + q) * D) + lane;
#pragma unroll
            for (int j = 0; j < 4; ++j) v[q][j] = xr[64 * j]; }
#pragma unroll
        for (int q = 0; q < 4; ++q) { float s = 0.f;
#pragma unroll
            for (int j = 0; j < 4; ++j) s += (v[q][j][0] * v[q][j][0] + v[q][j][1] * v[q][j][1]) + (v[q][j][2] * v[q][j][2] + v[q][j][3] * v[q][j][3]);
            const float rstd = __builtin_amdgcn_rsqf(wave_sum(s) * (1.f / D) + EPS);
            v2u* o8 = (v2u*)(F.XN + (size_t)(m0 + q) * D) + lane;
#pragma unroll
            for (int j = 0; j < 4; ++j) { const f32x4 g = *((const f32x4*)F.attn_g + lane + 64 * j); const f32x4 y = v[q][j] * rstd * g; o8[64 * j] = (v2u){pk2(y[0], y[1]), pk2(y[2], y[3])}; } }
    }
}

template <int NU> __device__ __forceinline__ void sgu_units(Frame& F, const int (&nbs)[2], int g, bool load_w) {
    LAS unsigned char* WmL = F.lds + 2 * 34816;
    const int tid = F.tid, lane = F.lane, w = F.wave, fr = lane & 15, fq = lane >> 4;
    v2u uu8[NU][8];
#pragma unroll
    for (int q2 = 0; q2 < NU; ++q2) { const bf16* up = F.PROJ + (size_t)(nbs[q2] * 128 + 16 * w + fr) * DIN + C_U + g * 128 + 4 * fq;
#pragma unroll
        for (int mt = 0; mt < 8; ++mt) uu8[q2][mt] = *(const v2u*)(up + 16 * mt); }
    v4u rr[NU][4];
    { const int j = tid >> 2, q = tid & 3;
#pragma unroll
      for (int q2 = 0; q2 < NU; ++q2) { const v4u* src = (const v4u*)(F.PROJ + (size_t)(nbs[q2] * 128 + j) * DIN + C_V + g * 128 + 32 * q);
#pragma unroll
          for (int i = 0; i < 4; ++i) rr[q2][i] = src[i]; } }
    if (load_w) {
        const int row = tid >> 2;
#pragma unroll
        for (int c = 0; c < 4; ++c) { const int chunk = (tid & 3) + 4 * c; *(LAS v4u*)(WmL + row * 272 + chunk * 16) = *(const v4u*)(F.SGUW + (size_t)(g * 128 + row) * 128 + chunk * 8); }
    }
#pragma unroll
    for (int q2 = 0; q2 < NU; ++q2) {
        LAS unsigned char* VnT = F.lds + q2 * 34816;
        const int j = tid >> 2, q = tid & 3;
        float v[32]; float ss = 0.f;
#pragma unroll
        for (int i = 0; i < 4; ++i) { v[8 * i + 0] = bflo(rr[q2][i].x); v[8 * i + 1] = bfhi(rr[q2][i].x); v[8 * i + 2] = bflo(rr[q2][i].y); v[8 * i + 3] = bfhi(rr[q2][i].y);
            v[8 * i + 4] = bflo(rr[q2][i].z); v[8 * i + 5] = bfhi(rr[q2][i].z); v[8 * i + 6] = bflo(rr[q2][i].w); v[8 * i + 7] = bfhi(rr[q2][i].w); }
#pragma unroll
        for (int i = 0; i < 32; ++i) ss += v[i] * v[i];
        ss += __shfl_xor(ss, 1); ss += __shfl_xor(ss, 2);
        const float rstd = __builtin_amdgcn_rsqf(ss * (1.f / 128.f) + EPS);
        const float* gvp = F.sgu_norm_g + g * 128 + 32 * q;
#pragma unroll
        for (int i = 0; i < 32; ++i) *(LAS bf16*)(VnT + (32 * q + i) * 272 + j * 2) = (bf16)f2bf(v[i] * rstd * gvp[i]);
    }
    __syncthreads();
#pragma unroll
    for (int q2 = 0; q2 < NU; ++q2) {
        LAS unsigned char* VnT = F.lds + q2 * 34816;
        f32x4 acc[8];
#pragma unroll
        for (int mt = 0; mt < 8; ++mt) acc[mt] = (f32x4){0.f, 0.f, 0.f, 0.f};
        const int nks = (w < 4) ? 2 : 4;
#pragma unroll
        for (int ks = 0; ks < 4; ++ks) if (ks < nks) {
            const bf16x8 b = *(const LAS bf16x8*)(WmL + (16 * w + fr) * 272 + (32 * ks + 8 * fq) * 2);
#pragma unroll
            for (int mt = 0; mt < 8; ++mt) { const bf16x8 a = *(const LAS bf16x8*)(VnT + (16 * mt + fr) * 272 + (32 * ks + 8 * fq) * 2);
                acc[mt] = __builtin_amdgcn_mfma_f32_16x16x32_bf16(a, b, acc[mt], 0, 0, 0); }
        }
        const int i = 16 * w + fr, t = nbs[q2] * 128 + i;
        const float bias = F.sgu_b[g * 128 + i];
        float yv[8][4]; float ss = 0.f;
#pragma unroll
        for (int mt = 0; mt < 8; ++mt) { const v2u uu = uu8[q2][mt];
            yv[mt][0] = bflo(uu.x) * (acc[mt][0] + bias); yv[mt][1] = bfhi(uu.x) * (acc[mt][1] + bias); yv[mt][2] = bflo(uu.y) * (acc[mt][2] + bias); yv[mt][3] = bfhi(uu.y) * (acc[mt][3] + bias);
            ss += (yv[mt][0] * yv[mt][0] + yv[mt][1] * yv[mt][1]) + (yv[mt][2] * yv[mt][2] + yv[mt][3] * yv[mt][3]); }
        ss += __shfl_xor(ss, 16); ss += __shfl_xor(ss, 32);
        const float rstd = __builtin_amdgcn_rsqf(ss * (1.f / 128.f) + EPS);
        const float* gop = F.ons_g + g * 128 + 4 * fq; bf16* yp = F.Y + (size_t)t * D + CW + g * 128 + 4 * fq;
#pragma unroll
        for (int mt = 0; mt < 8; ++mt) { const f32x4 gg = *(const f32x4*)(gop + 16 * mt);
            *(v2u*)(yp + 16 * mt) = (v2u){pk2(yv[mt][0] * rstd * gg[0], yv[mt][1] * rstd * gg[1]), pk2(yv[mt][2] * rstd * gg[2], yv[mt][3] * rstd * gg[3])}; }
    }
    __syncthreads();
}
__device__ __forceinline__ void p2_mixer(Frame& F) {
    const int lane = F.lane;
    {
        const int NUNIT = (M / 128) * 4; int loaded_g = -1; int u = blockIdx.x;
        if (F.G % 4 == 0) for (; u + F.G < NUNIT; u += 2 * F.G) { const int nbs[2] = {u >> 2, (u + F.G) >> 2}; const int g = u & 3; sgu_units<2>(F, nbs, g, loaded_g != g); loaded_g = g; }
        for (; u < NUNIT; u += F.G) { const int nbs[2] = {u >> 2, u >> 2}; const int g = u & 3; sgu_units<1>(F, nbs, g, loaded_g != g); loaded_g = g; }
    }
    for (int cu = F.gw; cu < M / 8; cu += F.NGW) {
        const int t0 = cu * 8, c0 = 8 * lane;
        v4u cb[10], hbv[10];
#pragma unroll
        for (int k = 0; k < 10; ++k) { const int tr = t0 - 2 + k; const bf16* row = F.PROJ + (size_t)(tr < 0 ? 0 : tr) * DIN; cb[k] = *(const v4u*)(row + C_C + c0); hbv[k] = *(const v4u*)(row + C_H + c0); }
        float w0[8], w1[8], w2[8], go[8];
#pragma unroll
        for (int i = 0; i < 8; ++i) { w0[i] = F.conv_w[c0 + i]; w1[i] = F.conv_w[CW + c0 + i]; w2[i] = F.conv_w[2 * CW + c0 + i]; go[i] = F.onc_g[c0 + i]; }
        float z1[8], z2[8];
#pragma unroll
        for (int k = 0; k < 10; ++k) {
            const v4u c = cb[k], h = hbv[k]; float z[8];
            z[0] = bflo(c.x) * bflo(h.x); z[1] = bfhi(c.x) * bfhi(h.x); z[2] = bflo(c.y) * bflo(h.y); z[3] = bfhi(c.y) * bfhi(h.y);
            z[4] = bflo(c.z) * bflo(h.z); z[5] = bfhi(c.z) * bfhi(h.z); z[6] = bflo(c.w) * bflo(h.w); z[7] = bfhi(c.w) * bfhi(h.w);
            if (t0 == 0 && k < 2) {
#pragma unroll
                for (int i = 0; i < 8; ++i) z[i] = 0.f; }
            if (k >= 2) {
                const v4u b = *(const v4u*)(F.PROJ + (size_t)(t0 + k - 2) * DIN + C_B + c0); float bb[8], y[8];
                bb[0] = bflo(b.x); bb[1] = bfhi(b.x); bb[2] = bflo(b.y); bb[3] = bfhi(b.y); bb[4] = bflo(b.z); bb[5] = bfhi(b.z); bb[6] = bflo(b.w); bb[7] = bfhi(b.w);
                float ss = 0.f;
#pragma unroll
                for (int i = 0; i < 8; ++i) { y[i] = bb[i] * (w0[i] * z2[i] + w1[i] * z1[i] + w2[i] * z[i]); ss += y[i] * y[i]; }
                ss += __shfl_xor(ss, 1); ss += __shfl_xor(ss, 2); ss += __shfl_xor(ss, 4);
                const float rstd = __builtin_amdgcn_rsqf(ss * (1.f / 64.f) + EPS);
                v4u o; o.x = pk2(y[0] * rstd * go[0], y[1] * rstd * go[1]); o.y = pk2(y[2] * rstd * go[2], y[3] * rstd * go[3]); o.z = pk2(y[4] * rstd * go[4], y[5] * rstd * go[5]); o.w = pk2(y[6] * rstd * go[6], y[7] * rstd * go[7]);
                *(v4u*)(F.Y + (size_t)(t0 + k - 2) * D + c0) = o;
            }
#pragma unroll
            for (int i = 0; i < 8; ++i) { z2[i] = z1[i]; z1[i] = z[i]; }
        }
    }
}

__device__ __forceinline__ void ced(int& a, int& b) { const int hi = a > b ? a : b, lo = a > b ? b : a; a = hi; b = lo; }
template <int OFF> __device__ __forceinline__ void sort16_desc(int (&v)[64]) {
#pragma unroll
    for (int lk = 1; lk <= 4; ++lk) {
#pragma unroll
        for (int lj = lk - 1; lj >= 0; --lj) {
#pragma unroll
            for (int i = 0; i < 16; ++i) { const int k = 1 << lk, j = 1 << lj, l = i ^ j;
                if (l > i) { if ((i & k) == 0) ced(v[OFF + i], v[OFF + l]); else ced(v[OFF + l], v[OFF + i]); } }
        }
    }
}
template <int OA, int OB> __device__ __forceinline__ void merge16(int (&v)[64]) {
#pragma unroll
    for (int i = 0; i < 16; ++i) v[OA + i] = v[OA + i] > v[OB + 15 - i] ? v[OA + i] : v[OB + 15 - i];
#pragma unroll
    for (int lj = 3; lj >= 0; --lj) {
#pragma unroll
        for (int i = 0; i < 16; ++i) { const int j = 1 << lj, l = i ^ j; if (l > i) ced(v[OA + i], v[OA + l]); }
    }
}
__device__ __forceinline__ void top16_64(int (&v)[64]) {
    sort16_desc<0>(v); sort16_desc<16>(v); sort16_desc<32>(v); sort16_desc<48>(v);
    merge16<0, 16>(v); merge16<32, 48>(v); merge16<0, 32>(v);
}
__device__ __forceinline__ int f2key(float x) { const int b = __builtin_bit_cast(int, x); return b ^ ((b >> 31) & 0x7fffffff); }
__device__ __forceinline__ float key2f(int k) { return __builtin_bit_cast(float, k ^ ((k >> 31) & 0x7fffffff)); }

template <class Sched> __device__ __forceinline__ void p4b_topk(Frame& F, const Sched& S) {
    const int lane = F.lane, r = lane & 31, hh = lane >> 5, tid = F.tid;
    LAS unsigned char* keysL = F.lds;
    LAS unsigned* lut = (LAS unsigned*)(F.lds + 69632 + F.wave * 4096) + lane;
    pg8::Unit un, unn;
    bool has = S.next(0, un);
    v4u kreg[8]; bf16x8 bq[8];
    if (has) { const int row = tid >> 1, half = tid & 1; const v4u* src = (const v4u*)(F.KEYS + (size_t)(un.pn * 256 + row) * 128 + half * 64);
#pragma unroll
        for (int i = 0; i < 8; ++i) kreg[i] = src[i];
        const bf16* qn = F.Q + (size_t)(un.pm * 256 + F.wave * 32 + r) * NQ + un.pn * 256 + 8 * hh;
#pragma unroll
        for (int s = 0; s < 8; ++s) bq[s] = *(const bf16x8*)(qn + 16 * s); }
    for (int round = 0; has; ++round) {
        const int h = un.pn;
        const int t0 = un.pm * 256 + F.wave * 32;
        const bf16* qb0 = F.Q + (size_t)(t0 + r) * NQ + h * 256 + 8 * hh;
        __syncthreads();
        { const int row = tid >> 1, half = tid & 1; LAS v4u* dst = (LAS v4u*)(keysL + row * 272 + half * 128);
#pragma unroll
            for (int i = 0; i < 8; ++i) dst[i] = kreg[i]; }
        __syncthreads();
        const bool has_next = S.next(round + 1, unn);
        int v[64];
        int part0[16], part1[16];
#pragma unroll
        for (int i = 0; i < 16; ++i) { part0[i] = 0; part1[i] = 0; }
#pragma unroll 1
        for (int p = 0; p < 2; ++p) {
            f32x16 acc[4];
#pragma unroll
            for (int m = 0; m < 4; ++m)
#pragma unroll
                for (int e = 0; e < 16; ++e) acc[m][e] = 0.f;
            const LAS unsigned char* kb = keysL + (p * 128 + r) * 272 + 16 * hh;
#pragma unroll
            for (int s = 0; s < 8; ++s) {
#pragma unroll
                for (int m = 0; m < 4; ++m) { const bf16x8 a = *(const LAS bf16x8*)(kb + (32 * m) * 272 + 32 * s); acc[m] = __builtin_amdgcn_mfma_f32_32x32x16_bf16(a, bq[s], acc[m], 0, 0, 0); } }
            if (p == 0) {
#pragma unroll
                for (int s = 0; s < 8; ++s) bq[s] = *(const bf16x8*)(qb0 + 128 + 16 * s); }
#pragma unroll
            for (int m = 0; m < 4; ++m)
#pragma unroll
                for (int e = 0; e < 16; ++e) v[m * 16 + e] = (f2key(acc[m][e]) & ~127) | (32 * m + (e & 3) + 8 * (e >> 2)) | (4 * hh);
            top16_64(v);
#pragma unroll
            for (int i = 0; i < 16; ++i) { part0[i] = (p == 0) ? v[i] : part0[i]; part1[i] = (p == 0) ? part1[i] : v[i]; }
        }
        if (has_next) { const int row = tid >> 1, half = tid & 1; const v4u* src = (const v4u*)(F.KEYS + (size_t)(unn.pn * 256 + row) * 128 + half * 64);
#pragma unroll
            for (int i = 0; i < 8; ++i) kreg[i] = src[i];
            const bf16* qn = F.Q + (size_t)(unn.pm * 256 + F.wave * 32 + r) * NQ + unn.pn * 256 + 8 * hh;
#pragma unroll
            for (int s = 0; s < 8; ++s) bq[s] = *(const bf16x8*)(qn + 16 * s); }
#pragma unroll
        for (int i = 0; i < 16; ++i) { const int send = hh ? part0[i] : part1[i]; const int recv = __shfl_xor(send, 32); v[i] = hh ? part1[i] : part0[i]; v[16 + i] = recv; }
        merge16<0, 16>(v);
        int L0[16], L1[16];
#pragma unroll
        for (int i = 0; i < 16; ++i) { const int other = __shfl_xor(v[i], 32); L0[i] = hh ? other : v[i]; L1[i] = hh ? v[i] : other; }
#pragma unroll
        for (int i = 0; i < 16; ++i) lut[64 * i] = (unsigned)(L0[i] & 127) | ((unsigned)(L1[i] & 127) << 8);
        {
            float a0[16], a1[16];
#pragma unroll
            for (int i = 0; i < 16; ++i) { a0[i] = key2f(L0[i]); a1[i] = key2f(L1[i]); }
            int n = 0;
#pragma unroll
            for (int i = 0; i < 16; ++i)
#pragma unroll
                for (int j = 0; j < 16; ++j) if ((i + 1) * (j + 1) <= 16) { v[n] = (f2key(a0[i] + a1[j]) & ~255) | (i * 16 + j); ++n; }
#pragma unroll
            for (int k = 50; k < 64; ++k) v[k] = (int)0x80000000;
        }
        top16_64(v);
        float val[16], ex[16]; int eid[16]; float sum = 0.f;
#pragma unroll
        for (int k = 0; k < 16; ++k) { const int pos = v[k] & 255; const int i1 = (int)(lut[64 * (pos >> 4)] & 255u), i2 = (int)(lut[64 * (pos & 15)] >> 8); eid[k] = i1 * 128 + i2; val[k] = key2f(v[k] & ~255); }
#pragma unroll
        for (int k = 0; k < 16; ++k) { ex[k] = __expf(val[k] - val[0]); sum += ex[k]; }
        const float rs = 1.0f / sum;
        if (hh == 0) {
            v4u* ip = (v4u*)(F.IDX + (size_t)(t0 + r) * NSEL + h * 16); f32x4* gp = (f32x4*)(F.GATE + (size_t)(t0 + r) * NSEL + h * 16);
#pragma unroll
            for (int k = 0; k < 4; ++k) { ip[k] = (v4u){(unsigned)eid[4 * k], (unsigned)eid[4 * k + 1], (unsigned)eid[4 * k + 2], (unsigned)eid[4 * k + 3]};
                gp[k] = (f32x4){ex[4 * k] * rs, ex[4 * k + 1] * rs, ex[4 * k + 2] * rs, ex[4 * k + 3] * rs}; }
        }
        LDS_WAIT();
        has = has_next; un = unn;
    }
}

constexpr int P6_SL = 32, P6_SHIFT = 9, P6_ROWS = 8, P6_TOK = 8, P6_NCH = NSEL / P6_ROWS;
#ifndef P6_BAR_A
#define P6_BAR_A 1
#endif
#ifndef P6_BAR_B
#define P6_BAR_B 2
#endif
typedef _Float16 h16x2 __attribute__((ext_vector_type(2)));
__device__ __forceinline__ float gelu_fast(float v) {
    const float av = fabsf(v), t = __builtin_amdgcn_rcpf(av * 0.2316418882f + 1.0f);
    float q = t * 0.5307027145f + (-0.7265760135f); q = q * t + 0.7107068705f; q = q * t + (-0.142248368f); q = q * t + 0.127414796f; q = q * t;
    const float e = __builtin_amdgcn_exp2f((v * v) * (-0.72134752044f)); const float m = v * (q * e);
    return v < 0.f ? m : v - m;
}
__device__ __forceinline__ int p6_jmap(int lane) { return ((lane >> 5) << 2) | (((lane >> 4) & 1) << 1) | ((lane >> 3) & 1); }
__host__ __device__ constexpr int p6_lane_of(int j) { return 32 * (j >> 2) + 16 * ((j >> 1) & 1) + 8 * (j & 1); }
__device__ __forceinline__ void p6_issue(const LAS unsigned char* lstk, int first, __amdgpu_buffer_rsrc_t rs, int lane, int lane16, v4u (&rows)[P6_ROWS], v4u& ent) {
    ent = *(const LAS v4u*)(lstk + (first + p6_jmap(lane)) * 16);
    const unsigned e_x = ent.x;
#pragma unroll
    for (int j = 0; j < P6_ROWS; ++j) { const int e = __builtin_amdgcn_readlane((int)e_x, p6_lane_of(j)); rows[j] = __builtin_amdgcn_raw_buffer_load_b128(rs, lane16, e << 10, 0); }
}
__device__ __forceinline__ void p6_compute_a(LAS unsigned char* lstk, int first, const int (&hq)[4], int lane, const v4u (&uu)[P6_ROWS], const v4u& ent) {
    int d[8];
#pragma unroll
    for (int j = 0; j < 8; ++j) { const v4u u = uu[j]; int a = __builtin_amdgcn_sdot4((int)u.x, hq[0], 0, false); a = __builtin_amdgcn_sdot4((int)u.y, hq[1], a, false);
        a = __builtin_amdgcn_sdot4((int)u.z, hq[2], a, false); a = __builtin_amdgcn_sdot4((int)u.w, hq[3], a, false); d[j] = a; }
    int r1[4], r2[2];
#pragma unroll
    for (int i = 0; i < 4; ++i) { const auto q = __builtin_amdgcn_permlane32_swap((unsigned)d[i], (unsigned)d[i + 4], false, false); r1[i] = (int)(q[0] + q[1]); }
#pragma unroll
    for (int i = 0; i < 2; ++i) { const auto q = __builtin_amdgcn_permlane16_swap((unsigned)r1[i], (unsigned)r1[i + 2], false, false); r2[i] = (int)(q[0] + q[1]); }
    const bool b3 = lane & 8;
    int r3 = (b3 ? r2[1] : r2[0]) + __builtin_amdgcn_update_dpp(0, b3 ? r2[0] : r2[1], 0x128, 0xf, 0xf, false);
    r3 += __builtin_amdgcn_update_dpp(0, r3, 0xB1, 0xf, 0xf, false); r3 += __builtin_amdgcn_update_dpp(0, r3, 0x4E, 0xf, 0xf, false); r3 += __builtin_amdgcn_update_dpp(0, r3, 0x141, 0xf, 0xf, false);
    const unsigned e_y = ent.y, e_z = ent.z; const float dsv = __builtin_bit_cast(float, e_y), gsv = __builtin_bit_cast(float, e_z);
    const float cf = gsv * gelu_fast((float)r3 * dsv) * 256.0f;
    const h16x2 c2 = (h16x2){(_Float16)cf, (_Float16)cf};
    *(LAS unsigned*)(lstk + (first + p6_jmap(lane)) * 16 + 12) = __builtin_bit_cast(unsigned, c2);
}
template <bool HI> __device__ __forceinline__ h16x2 p6_cvt(unsigned w) { const auto r = __builtin_amdgcn_cvt_scalef32_pk_f16_fp8(w, 0.00390625f, HI); return __builtin_bit_cast(h16x2, r); }
__device__ __forceinline__ void p6_compute_b(int lane, const v4u (&vv)[P6_ROWS], const v4u& ent, h16x2 (&acc)[8]) {
    const unsigned e_w = ent.w;
#pragma unroll
    for (int j = 0; j < P6_ROWS; ++j) { const h16x2 c2 = __builtin_bit_cast(h16x2, (unsigned)__builtin_amdgcn_readlane((int)e_w, p6_lane_of(j)));
        const unsigned vw[4] = {vv[j].x, vv[j].y, vv[j].z, vv[j].w};
#pragma unroll
        for (int i = 0; i < 4; ++i) { acc[2 * i] = __builtin_elementwise_fma(c2, p6_cvt<false>(vw[i]), acc[2 * i]); acc[2 * i + 1] = __builtin_elementwise_fma(c2, p6_cvt<true>(vw[i]), acc[2 * i + 1]); } }
}
__device__ __forceinline__ void p6_peer(Frame& F) {
    const int lane = F.lane;
    LAS unsigned char* lst = F.lds + F.wave * 16384;
    const __amdgpu_buffer_rsrc_t rsU = __builtin_amdgcn_make_buffer_rsrc((void*)F.U8, 0, NEXP * D, 0x00020000), rsV = __builtin_amdgcn_make_buffer_rsrc((void*)F.V8, 0, NEXP * D, 0x00020000);
    const int lane16 = lane * 16;
    for (int tg0 = 0; tg0 < M / P6_TOK; tg0 += F.NGW) {
    const int tb = ((tg0 + F.gw < M / P6_TOK) ? tg0 + F.gw : M / P6_TOK - 1) * P6_TOK;
    int hq[P6_TOK][4];
    {
        v4u hb[P6_TOK][2]; int ia[P6_TOK], ib[P6_TOK]; float gta[P6_TOK], gtb[P6_TOK], ssq[P6_TOK];
#pragma unroll
        for (int k = 0; k < P6_TOK; ++k) {
            const int t = tb + k;
            const v4u* hp = (const v4u*)(F.HB + (size_t)t * D) + 2 * lane; hb[k][0] = hp[0]; hb[k][1] = hp[1];
            ia[k] = F.IDX[(size_t)t * NSEL + lane]; ib[k] = F.IDX[(size_t)t * NSEL + 64 + lane];
            gta[k] = F.GATE[(size_t)t * NSEL + lane]; gtb[k] = F.GATE[(size_t)t * NSEL + 64 + lane]; ssq[k] = F.sumsq[t];
        }
        f32x4 g4[4];
#pragma unroll
        for (int i = 0; i < 4; ++i) g4[i] = ((const f32x4*)F.ffn_g + 4 * lane)[i];
        float sua[P6_TOK], sub[P6_TOK], sva[P6_TOK], svb[P6_TOK];
#pragma unroll
        for (int k = 0; k < P6_TOK; ++k) { sua[k] = F.SU[ia[k]]; sub[k] = F.SU[ib[k]]; sva[k] = F.SV[ia[k]]; svb[k] = F.SV[ib[k]]; }
#pragma unroll
        for (int k = 0; k < P6_TOK; ++k) {
            const unsigned hw[8] = {hb[k][0].x, hb[k][0].y, hb[k][0].z, hb[k][0].w, hb[k][1].x, hb[k][1].y, hb[k][1].z, hb[k][1].w};
            float hf[16]; float amax = 0.f;
#pragma unroll
            for (int i = 0; i < 4; ++i) { hf[4 * i] = bflo(hw[2 * i]) * g4[i][0]; hf[4 * i + 1] = bfhi(hw[2 * i]) * g4[i][1]; hf[4 * i + 2] = bflo(hw[2 * i + 1]) * g4[i][2]; hf[4 * i + 3] = bfhi(hw[2 * i + 1]) * g4[i][3]; }
#pragma unroll
            for (int i = 0; i < 16; ++i) amax = fmaxf(amax, fabsf(hf[i]));
#pragma unroll
            for (int o = 1; o < 64; o <<= 1) amax = fmaxf(amax, __shfl_xor(amax, o));
            const float hsc = amax > 0.f ? 127.f / amax : 1.f, hinv = amax > 0.f ? amax * (1.f / 127.f) : 1.f;
#pragma unroll
            for (int i = 0; i < 4; ++i) hq[k][i] = (int)pack_i8(hf[4 * i] * hsc, hf[4 * i + 1] * hsc, hf[4 * i + 2] * hsc, hf[4 * i + 3] * hsc);
            const float inv = __builtin_amdgcn_rsqf(ssq[k] * (1.f / D) + EPS) * hinv;
            const float da = inv * sua[k], db = inv * sub[k];
            const float ga = gta[k] * sva[k], gb = gtb[k] * svb[k];
            const int sa = ia[k] >> P6_SHIFT, sb = ib[k] >> P6_SHIFT;
            LAS unsigned* hist = (LAS unsigned*)(lst + k * 2048);
            if (lane < P6_SL) hist[lane] = 0u;
            const unsigned rka = __hip_atomic_fetch_add(hist + sa, 1u, __ATOMIC_RELAXED, __HIP_MEMORY_SCOPE_WORKGROUP);
            const unsigned rkb = __hip_atomic_fetch_add(hist + sb, 1u, __ATOMIC_RELAXED, __HIP_MEMORY_SCOPE_WORKGROUP);
            unsigned cnt = (lane < P6_SL) ? hist[lane] : 0u, inc = cnt;
#pragma unroll
            for (int o = 1; o < P6_SL; o <<= 1) { const unsigned up = __shfl_up(inc, o); inc += (lane >= o) ? up : 0u; }
            if (lane < P6_SL) hist[P6_SL + lane] = inc - cnt;
            const int pa = (int)(hist[P6_SL + sa] + rka), pb = (int)(hist[P6_SL + sb] + rkb);
            LDS_WAIT();
            *(LAS v4u*)(lst + k * 2048 + pa * 16) = (v4u){(unsigned)ia[k], __builtin_bit_cast(unsigned, da), __builtin_bit_cast(unsigned, ga), 0u};
            *(LAS v4u*)(lst + k * 2048 + pb * 16) = (v4u){(unsigned)ib[k], __builtin_bit_cast(unsigned, db), __builtin_bit_cast(unsigned, gb), 0u};
        }
    }
    v4u r0[P6_ROWS], r1[P6_ROWS]; v4u e0, e1;
#define P6_ISSUE(SET, kk, cc, RS) p6_issue(lst + (kk) * 2048, (cc) * P6_ROWS, RS, lane, lane16, r##SET, e##SET)
#define P6_CA(SET, kk, cc) p6_compute_a(lst + (kk) * 2048, (cc) * P6_ROWS, hq[kk], lane, r##SET, e##SET)
    P6_ISSUE(0, 0, 0, rsU);
    for (int c = 0; c < P6_NCH; ++c) {
        if (P6_BAR_A && (c % (P6_BAR_A ? P6_BAR_A : 1)) == 0) __builtin_amdgcn_s_barrier();
        const int cn = (c + 1 < P6_NCH) ? c + 1 : c;
        P6_ISSUE(1, 1, c, rsU); P6_CA(0, 0, c);  P6_ISSUE(0, 2, c, rsU); P6_CA(1, 1, c);  P6_ISSUE(1, 3, c, rsU); P6_CA(0, 2, c);  P6_ISSUE(0, 4, c, rsU); P6_CA(1, 3, c);
        P6_ISSUE(1, 5, c, rsU); P6_CA(0, 4, c);  P6_ISSUE(0, 6, c, rsU); P6_CA(1, 5, c);  P6_ISSUE(1, 7, c, rsU); P6_CA(0, 6, c);  P6_ISSUE(0, 0, cn, rsU); P6_CA(1, 7, c);
    }
#undef P6_CA
    h16x2 acc[P6_TOK][8];
#pragma unroll
    for (int k = 0; k < P6_TOK; ++k)
#pragma unroll
        for (int i = 0; i < 8; ++i) acc[k][i] = (h16x2){(_Float16)0.f, (_Float16)0.f};
#define P6_CB(SET, kk) p6_compute_b(lane, r##SET, e##SET, acc[kk])
    P6_ISSUE(0, 0, 0, rsV);
    for (int c = 0; c < P6_NCH; ++c) {
        if (P6_BAR_B && (c % (P6_BAR_B ? P6_BAR_B : 1)) == 0) __builtin_amdgcn_s_barrier();
        const int cn = (c + 1 < P6_NCH) ? c + 1 : c;
        P6_ISSUE(1, 1, c, rsV); P6_CB(0, 0);  P6_ISSUE(0, 2, c, rsV); P6_CB(1, 1);  P6_ISSUE(1, 3, c, rsV); P6_CB(0, 2);  P6_ISSUE(0, 4, c, rsV); P6_CB(1, 3);
        P6_ISSUE(1, 5, c, rsV); P6_CB(0, 4);  P6_ISSUE(0, 6, c, rsV); P6_CB(1, 5);  P6_ISSUE(1, 7, c, rsV); P6_CB(0, 6);  P6_ISSUE(0, 0, cn, rsV); P6_CB(1, 7);
    }
#undef P6_CB
#undef P6_ISSUE
    v4u hbt[P6_TOK][2];
#pragma unroll
    for (int k = 0; k < P6_TOK; ++k) { const v4u* hbp = (const v4u*)(F.HB + (size_t)(tb + k) * D) + 2 * lane; hbt[k][0] = hbp[0]; hbt[k][1] = hbp[1]; }
    f32x4 fg[4];
#pragma unroll
    for (int i = 0; i < 4; ++i) fg[i] = ((const f32x4*)F.final_g + 4 * lane)[i];
#pragma unroll
    for (int k = 0; k < P6_TOK; ++k) {
        const int t = tb + k;
        const unsigned hww[8] = {hbt[k][0].x, hbt[k][0].y, hbt[k][0].z, hbt[k][0].w, hbt[k][1].x, hbt[k][1].y, hbt[k][1].z, hbt[k][1].w};
        f32x4* orow = (f32x4*)(F.out + (size_t)t * D) + 4 * lane;
        f32x4 hv[4]; float ss = 0.f;
#pragma unroll
        for (int i = 0; i < 4; ++i) { hv[i][0] = bflo(hww[2 * i]) + (float)acc[k][2 * i].x; hv[i][1] = bfhi(hww[2 * i]) + (float)acc[k][2 * i].y; hv[i][2] = bflo(hww[2 * i + 1]) + (float)acc[k][2 * i + 1].x; hv[i][3] = bfhi(hww[2 * i + 1]) + (float)acc[k][2 * i + 1].y;
            ss += (hv[i][0] * hv[i][0] + hv[i][1] * hv[i][1]) + (hv[i][2] * hv[i][2] + hv[i][3] * hv[i][3]); }
        float rstd = __builtin_amdgcn_rsqf(wave_sum(ss) * (1.f / D) + EPS);
#pragma unroll
        for (int i = 0; i < 4; ++i) orow[i] = hv[i] * rstd * fg[i];
    }
    }
}

constexpr int N_PHASES = 7;
struct Args { const float* in[16]; float* out; unsigned char* ws; int ph_lo, ph_hi; };
static_assert(sizeof(Args) == 16 * 8 + 8 + 8 + 8, "Args has no padding");
__global__ void __launch_bounds__(NWAVES * 64, 2) fwd_kernel(Args args) {
    extern __shared__ __attribute__((aligned(16))) unsigned char lds[];
    Frame F;
    F.lds = (LAS unsigned char*)lds;
    F.MISC = (volatile LAS unsigned*)(F.lds + MISC_OFF);
    F.tid = threadIdx.x; F.lane = F.tid & 63; F.wave = __builtin_amdgcn_readfirstlane(F.tid >> 6);
    F.G = gridDim.x; { const int bx = blockIdx.x; F.vcu = (F.G % 8 == 0) ? (bx % 8) * (F.G / 8) + bx / 8 : bx; }
    F.gw = F.vcu * NWAVES + F.wave; F.NGW = F.G * NWAVES;
    frame_ptrs(F, args.in, args.out, args.ws);
    for (int u = F.tid; u < (LDS_BYTES - LDSCTL_OFF) / 4; u += NWAVES * 64) ((LAS unsigned*)(F.lds + LDSCTL_OFF))[u] = 0u;
    __syncthreads();
    const int lo = args.ph_lo, hi = args.ph_hi;
    const bool use_bar = (hi - lo) > 1;
    XcdBarrier bar; bar.bar = (unsigned*)(F.ctl + CW_BAR); bar.x = 0; bar.st = nullptr;
    if (use_bar) bar = xcd_barrier_post((unsigned*)(F.ctl + CW_BAR), F.MISC + 8);
#define IN(k) (lo <= (k) && (k) < hi)
#define SEAM(k) do { if (IN(k) && IN((k) + 1)) xcd_barrier(bar); } while (0)
    if (IN(0)) { p0_prologue(F); SEAM(0); }
    if (IN(1)) {
        pg8::Gemm g{F.XN, F.WinT, M, DIN, D}; pg8::StaticOrder S; S.init(M, DIN, F.G, (int)blockIdx.x);
        pg8::EpiProj E{F.PROJ, DIN, C_U / 256};
        pg8::gemm_phase<pg8::EpiProj, pg8::StaticOrder, true, true>(F.lds, g, S, E);
        { const int nwg = (M / 256) * (DIN / 256), rem = nwg % F.G;
          const int first = rem ? rem : 0, nconv = F.G - first;
          if ((int)blockIdx.x >= first) late_weights(F, ((int)blockIdx.x - first) * NWAVES + F.wave, nconv * NWAVES); }
        SEAM(1);
    }
    if (IN(2)) { p2_mixer(F); SEAM(2); }
    if (IN(3)) {
        pg8::Gemm g{F.Y, F.WoutT, M, D, D}; pg8::StaticOrder S; S.init(M, D, F.G, (int)blockIdx.x);
        pg8::EpiH E{F.x, F.HB, F.sumsq, D};
        pg8::gemm_phase<pg8::EpiH, pg8::StaticOrder, true, true>(F.lds, g, S, E);
        SEAM(3);
    }
    if (IN(4)) {
        pg8::Gemm g{F.HB, F.WqT, M, NQ, D}; pg8::StaticOrder S; S.init(M, NQ, F.G, (int)blockIdx.x);
        pg8::EpiQ E{F.Q, NQ, F.sumsq, 1.f / D, EPS};
        pg8::gemm_phase<pg8::EpiQ, pg8::StaticOrder, true, true>(F.lds, g, S, E);
        VM_WAIT(); __syncthreads();
        p4b_topk(F, S);
        convert_tables(F, F.gw, F.NGW, 0, 2 * NEXP);
        SEAM(5);
    }
    if (IN(6)) p6_peer(F);
#undef IN
#undef SEAM
}

#ifndef NV_P1
#define NV_P1 (MK_MODE == 0)
#endif
#ifndef NV_P2
#define NV_P2 (MK_MODE == 0)
#endif
#ifndef NV_P3
#define NV_P3 (MK_MODE == 0)
#endif
#ifndef NV_P4
#define NV_P4 (MK_MODE == 0)
#endif
#ifndef NV_P5
#define NV_P5 (MK_MODE == 0)
#endif
#ifndef NV_P6
#define NV_P6 (MK_MODE == 0)
#endif
#define NV_ANY (NV_P1 || NV_P2 || NV_P3 || NV_P4 || NV_P5 || NV_P6)
#if NV_ANY
template <class Epi> __global__ void __launch_bounds__(256) nv_gemm(const bf16* A, const bf16* Bt, int K, Epi E) {
    __shared__ float As[16][65], Bs[16][65];
    const int tx = threadIdx.x & 15, ty = threadIdx.x >> 4, m0 = blockIdx.y * 64, n0 = blockIdx.x * 64;
    float acc[4][4];
#pragma unroll
    for (int i = 0; i < 4; ++i)
#pragma unroll
        for (int j = 0; j < 4; ++j) acc[i][j] = 0.f;
    for (int k0 = 0; k0 < K; k0 += 16) {
        for (int i = threadIdx.x; i < 1024; i += 256) { const int r = i >> 4, c = i & 15; As[c][r] = bf2f(A[(size_t)(m0 + r) * K + k0 + c]); Bs[c][r] = bf2f(Bt[(size_t)(n0 + r) * K + k0 + c]); }
        __syncthreads();
#pragma unroll
        for (int kk = 0; kk < 16; ++kk)
#pragma unroll
            for (int i = 0; i < 4; ++i)
#pragma unroll
                for (int j = 0; j < 4; ++j) acc[i][j] += As[kk][ty * 4 + i] * Bs[kk][tx * 4 + j];
        __syncthreads();
    }
#pragma unroll
    for (int i = 0; i < 4; ++i)
#pragma unroll
        for (int j = 0; j < 4; ++j) E(m0 + ty * 4 + i, n0 + tx * 4 + j, acc[i][j]);
}
struct NvEpiProj { bf16* O; __device__ void operator()(int r, int c, float v) const { O[(size_t)r * DIN + c] = (bf16)f2bf(c >= C_U ? gelu_exact(v) : v); } };
struct NvEpiH { const float* X; float* H; bf16* HB; __device__ void operator()(int r, int c, float v) const { const float h = X[(size_t)r * D + c] + v; H[(size_t)r * D + c] = h; HB[(size_t)r * D + c] = (bf16)f2bf(h); } };
struct NvEpiQ { bf16* O; const float* sumsq; __device__ void operator()(int r, int c, float v) const { O[(size_t)r * NQ + c] = (bf16)f2bf(v * (1.0f / sqrtf(sumsq[r] * (1.f / D) + EPS))); } };
__global__ void __launch_bounds__(256) nv_rowss(const float* H, float* sumsq) {
    const int row = blockIdx.x * 4 + (threadIdx.x >> 6), lane = threadIdx.x & 63; float s = 0.f;
    for (int c = lane; c < D; c += 64) { const float h = H[(size_t)row * D + c]; s += h * h; }
    s = wave_sum(s); if (lane == 0) sumsq[row] = s;
}
__global__ void __launch_bounds__(256) nv_mix1(const bf16* PROJ, const float* gv, float* VN) {
    const int t = blockIdx.x, c = threadIdx.x * 2; const float a = bf2f(PROJ[(size_t)t * DIN + C_V + c]), b = bf2f(PROJ[(size_t)t * DIN + C_V + c + 1]);
    float ss = a * a + b * b;
    ss = wave_sum(ss);
    const float rstd = 1.0f / sqrtf(ss * (1.f / 128.f) + EPS);
    VN[(size_t)t * SW + c] = a * rstd * gv[c]; VN[(size_t)t * SW + c + 1] = b * rstd * gv[c + 1];
}
__global__ void __launch_bounds__(256) nv_mix2(const bf16* PROJ, const float* VN, const float* conv_w, const float* sgu_w, const float* sgu_b, float* YP) {
    const int t = blockIdx.x, tid = threadIdx.x;
    for (int c = tid; c < D; c += 256) {
        float y;
        if (c < CW) {
            float conv = 0.f;
            for (int k = 0; k < 3; ++k) { const int ts = t - 2 + k; if (ts >= 0) conv += conv_w[k * CW + c] * (bf2f(PROJ[(size_t)ts * DIN + C_C + c]) * bf2f(PROJ[(size_t)ts * DIN + C_H + c])); }
            y = bf2f(PROJ[(size_t)t * DIN + C_B + c]) * conv;
        } else {
            const int cc = c - CW, g = cc >> 7, i = t & 127, nb = t >> 7; float mix = sgu_b[g * 128 + i];
            for (int j = 0; j < 128; ++j) if ((i >> 6) >= (j >> 6)) mix += sgu_w[(size_t)(g * 128 + i) * 128 + j] * VN[(size_t)(nb * 128 + j) * SW + cc];
            y = bf2f(PROJ[(size_t)t * DIN + C_U + cc]) * mix;
        }
        YP[(size_t)t * D + c] = y;
    }
}
__global__ void __launch_bounds__(256) nv_mix3(const float* YP, const float* gc, const float* gs, bf16* Y) {
    const int t = blockIdx.x, c = threadIdx.x * 4; float v[4], ss = 0.f;
#pragma unroll
    for (int i = 0; i < 4; ++i) { v[i] = YP[(size_t)t * D + c + i]; ss += v[i] * v[i]; }
    ss += __shfl_xor(ss, 1); ss += __shfl_xor(ss, 2); ss += __shfl_xor(ss, 4); ss += __shfl_xor(ss, 8);
    float n = 64.f; if (c >= CW) { ss += __shfl_xor(ss, 16); n = 128.f; }
    const float rstd = 1.0f / sqrtf(ss / n + EPS);
#pragma unroll
    for (int i = 0; i < 4; ++i) { const float g = c < CW ? gc[c + i] : gs[c - CW + i]; Y[(size_t)t * D + c + i] = (bf16)f2bf(v[i] * rstd * g); }
}
__global__ void __launch_bounds__(64) nv_topk(const bf16* Q, const bf16* KEYS, int* IDX, float* GATE) {
    __shared__ float sc[32][257]; __shared__ float tv[32][2][16]; __shared__ int ti[32][2][16]; __shared__ unsigned char used[32][256];
    const int tid = threadIdx.x; if (tid >= 32) return;
    const int h = blockIdx.x & 7, t = (blockIdx.x >> 3) * 32 + tid;
    for (int p = 0; p < 2; ++p) for (int k = 0; k < 128; ++k) { float s = 0.f;
        for (int d = 0; d < 128; ++d) s += bf2f(Q[(size_t)t * NQ + h * 256 + p * 128 + d]) * bf2f(KEYS[(size_t)((h * 2 + p) * 128 + k) * 128 + d]);
        sc[tid][p * 128 + k] = s; }
    for (int p = 0; p < 2; ++p) for (int n = 0; n < 16; ++n) { float best = -3.0e38f; int bi = 0;
        for (int k = 0; k < 128; ++k) { const float s = sc[tid][p * 128 + k]; if (s > best) { best = s; bi = k; } }
        tv[tid][p][n] = best; ti[tid][p][n] = bi; sc[tid][p * 128 + bi] = -3.0e38f; }
    for (int k = 0; k < 256; ++k) used[tid][k] = 0;
    float mx = -3.0e38f, sum = 0.f;
    for (int n = 0; n < 16; ++n) { float best = -3.0e38f; int bi = 0;
        for (int k = 0; k < 256; ++k) { if (used[tid][k]) continue; const float s = tv[tid][0][k >> 4] + tv[tid][1][k & 15]; if (s > best) { best = s; bi = k; } }
        used[tid][bi] = 1; sc[tid][n] = best; IDX[(size_t)t * NSEL + h * 16 + n] = ti[tid][0][bi >> 4] * 128 + ti[tid][1][bi & 15]; if (best > mx) mx = best; }
    for (int n = 0; n < 16; ++n) { const float e = expf(sc[tid][n] - mx); sc[tid][16 + n] = e; sum += e; }
    for (int n = 0; n < 16; ++n) GATE[(size_t)t * NSEL + h * 16 + n] = sc[tid][16 + n] / sum;
}
__device__ __forceinline__ float fp8f(unsigned char b) { return __builtin_amdgcn_cvt_f32_fp8((int)b, 0); }
__global__ void __launch_bounds__(256) nv_peer(const bf16* HB, const float* sumsq, const int* IDX, const float* GATE, const unsigned char* U8, const unsigned char* V8, const float* SU, const float* SV, const float* gf, const float* fg, float* H) {
    __shared__ float hn[D]; __shared__ float coef[NSEL]; __shared__ float red[4];
    const int t = blockIdx.x, tid = threadIdx.x, lane = tid & 63, w = tid >> 6;
    const float inv = 1.0f / sqrtf(sumsq[t] * (1.f / D) + EPS);
    for (int c = tid; c < D; c += 256) hn[c] = bf2f(HB[(size_t)t * D + c]) * gf[c] * inv;
    __syncthreads();
    for (int e = w; e < NSEL; e += 4) { const int id = IDX[(size_t)t * NSEL + e]; float d = 0.f;
        for (int c = lane; c < D; c += 64) d += (float)(signed char)U8[(size_t)id * D + c] * hn[c];
        d = wave_sum(d); if (lane == 0) coef[e] = GATE[(size_t)t * NSEL + e] * gelu_exact(d * SU[id]) * SV[id]; }
    __syncthreads();
    float o[4]; float ss = 0.f;
#pragma unroll
    for (int i = 0; i < 4; ++i) { const int c = tid + 256 * i; float a = 0.f; for (int e = 0; e < NSEL; ++e) a += coef[e] * fp8f(V8[(size_t)IDX[(size_t)t * NSEL + e] * D + c]); o[i] = H[(size_t)t * D + c] + a; ss += o[i] * o[i]; }
    ss = wave_sum(ss); if (lane == 0) red[w] = ss;
    __syncthreads();
    const float rstd = 1.0f / sqrtf((red[0] + red[1] + red[2] + red[3]) * (1.f / D) + EPS);
#pragma unroll
    for (int i = 0; i < 4; ++i) { const int c = tid + 256 * i; H[(size_t)t * D + c] = o[i] * rstd * fg[c]; }
}
#endif

static void launch_phases(const Args& base, int lo, int hi, int grid, hipStream_t stream) {
    Args a = base; a.ph_lo = lo; a.ph_hi = hi;
    hipLaunchKernelGGL(fwd_kernel, dim3(grid), dim3(NWAVES * 64), LDS_BYTES, stream, a);
    const hipError_t le = hipPeekAtLastError();
    if (le != hipSuccess) fprintf(stderr, "kernel_launch: launch of phases [%d,%d) failed: %s\n", lo, hi, hipGetErrorName(le));
}
extern "C" void kernel_launch(void* const* d_in, const int* in_sizes, int n_in, void* d_out, int out_size, void* d_ws, size_t ws_size, hipStream_t stream) {
    static int grid = 0;
    if (grid == 0) {
        if (n_in != 16 || in_sizes[0] != M * D || out_size != M * D || ws_size < WS_END) { fprintf(stderr, "kernel_launch: unexpected shapes (n_in %d, in0 %d, out %d, ws %zu); nothing launched\n", n_in, n_in > 0 ? in_sizes[0] : -1, out_size, ws_size); grid = -1; return; }
        int dev = 0, cus = 0, per_cu = 0;
        if (hipGetDevice(&dev) != hipSuccess || hipDeviceGetAttribute(&cus, hipDeviceAttributeMultiprocessorCount, dev) != hipSuccess) { fprintf(stderr, "kernel_launch: device query failed\n"); grid = -1; return; }
        if (hipFuncSetAttribute((const void*)fwd_kernel, hipFuncAttributeMaxDynamicSharedMemorySize, LDS_BYTES) != hipSuccess) { fprintf(stderr, "kernel_launch: hipFuncSetAttribute failed\n"); grid = -1; return; }
        if (hipOccupancyMaxActiveBlocksPerMultiprocessor(&per_cu, (const void*)fwd_kernel, NWAVES * 64, LDS_BYTES) != hipSuccess || per_cu < 1) { fprintf(stderr, "kernel_launch: occupancy query reports %d workgroups per CU; nothing launched\n", per_cu); (void)hipGetLastError(); grid = -1; return; }
        grid = cus;
        if (grid % 8 != 0 || grid > 256) grid = (grid > 256) ? 256 : (grid / 8) * 8;
        if (grid < 8) { fprintf(stderr, "kernel_launch: too few CUs (%d)\n", cus); grid = -1; return; }
    }
    if (grid < 0) return;
    if (hipMemsetAsync((char*)d_ws + WS_CTL, 0, CTL_ZERO_BYTES, stream) != hipSuccess) { fprintf(stderr, "kernel_launch: hipMemsetAsync failed\n"); return; }
    Args a{};
    for (int i = 0; i < 16; ++i) a.in[i] = (const float*)d_in[i];
    a.out = (float*)d_out; a.ws = (unsigned char*)d_ws;
#if MK_MODE == 2
    launch_phases(a, 0, N_PHASES, grid, stream);
#else
    unsigned char* ws = (unsigned char*)d_ws; float* out = (float*)d_out;
    bf16 *WinT = (bf16*)(ws + WS_WIN), *WoutT = (bf16*)(ws + WS_WOUT), *WqT = (bf16*)(ws + WS_WQ), *KEYS = (bf16*)(ws + WS_KEYS); unsigned char *U8 = ws + WS_U8, *V8 = ws + WS_V8; float *SU = (float*)(ws + WS_SU), *SV = (float*)(ws + WS_SV);
    bf16 *XN = (bf16*)(ws + WS_XN), *Y = (bf16*)(ws + WS_Y), *PROJ = (bf16*)(ws + WS_PROJ), *Q = (bf16*)(ws + WS_Q), *HB = (bf16*)(ws + WS_HB);
    int* IDX = (int*)(ws + WS_IDX); float* GATE = (float*)(ws + WS_GATE); float* sumsq = (float*)(ws + WS_CTL) + CW_SUMSQ;
    (void)WinT; (void)WoutT; (void)WqT; (void)KEYS; (void)U8; (void)V8; (void)SU; (void)SV; (void)XN; (void)Y; (void)PROJ; (void)Q; (void)HB; (void)IDX; (void)GATE; (void)sumsq; (void)out;
    launch_phases(a, 0, 1, grid, stream);
#if NV_P1
    hipLaunchKernelGGL(nv_gemm<NvEpiProj>, dim3(DIN / 64, M / 64), dim3(256), 0, stream, (const bf16*)XN, (const bf16*)WinT, D, NvEpiProj{PROJ});
    launch_phases(a, 1, 2, grid, stream);
#else
    launch_phases(a, 1, 2, grid, stream);
#endif
#if NV_P2
    { float* VN = (float*)(ws + WS_HB);
      hipLaunchKernelGGL(nv_mix1, dim3(M), dim3(256), 0, stream, (const bf16*)PROJ, a.in[6], VN);
      hipLaunchKernelGGL(nv_mix2, dim3(M), dim3(256), 0, stream, (const bf16*)PROJ, (const float*)VN, a.in[3], a.in[4], a.in[5], out);
      hipLaunchKernelGGL(nv_mix3, dim3(M), dim3(256), 0, stream, (const float*)out, a.in[7], a.in[8], Y); }
#else
    launch_phases(a, 2, 3, grid, stream);
#endif
#if NV_P3
    hipLaunchKernelGGL(nv_gemm<NvEpiH>, dim3(D / 64, M / 64), dim3(256), 0, stream, (const bf16*)Y, (const bf16*)WoutT, D, NvEpiH{a.in[0], out, HB});
    hipLaunchKernelGGL(nv_rowss, dim3(M / 4), dim3(256), 0, stream, (const float*)out, sumsq);
#else
    launch_phases(a, 3, 4, grid, stream);
#endif
#if NV_P4
    hipLaunchKernelGGL(nv_gemm<NvEpiQ>, dim3(NQ / 64, M / 64), dim3(256), 0, stream, (const bf16*)HB, (const bf16*)WqT, D, NvEpiQ{Q, sumsq});
    launch_phases(a, 4, 5, grid, stream);
#else
    launch_phases(a, 4, 5, grid, stream);
#endif
#if NV_P5
    hipLaunchKernelGGL(nv_topk, dim3((M / 32) * NH), dim3(64), 0, stream, (const bf16*)Q, (const bf16*)KEYS, IDX, GATE);
#else
    launch_phases(a, 5, 6, grid, stream);
#endif
#if NV_P6
    hipLaunchKernelGGL(nv_peer, dim3(M), dim3(256), 0, stream, (const bf16*)HB, (const float*)sumsq, (const int*)IDX, (const float*)GATE, (const unsigned char*)U8, (const unsigned char*)V8, (const float*)SU, (const float*)SV, a.in[10], a.in[15], out);
#else
    launch_phases(a, 6, 7, grid, stream);
#endif
#endif
}
```

```cpp
#include <hip/hip_runtime.h>
#include <cstdio>
#include <cstdint>
#ifndef MK_MODE
#define MK_MODE 2
#endif
namespace pg8 {
#define PG8_LAS __attribute__((address_space(3)))
typedef unsigned short bf16_t;
typedef short bf16x8 __attribute__((ext_vector_type(8)));
typedef float f32x4 __attribute__((ext_vector_type(4)));
typedef unsigned u32x4 __attribute__((ext_vector_type(4)));
constexpr int BM = 256, BK = 64, HALF = 128, HTB = HALF * BK * 2  , STAGE_BYTES = 8 * HTB, NXCD = 8, WGM = 8;

__host__ __device__ __forceinline__ int lds_byte(int r, int c) { const int st = (r >> 4) * 2 + (c >> 5), rr = r & 15, cc = c & 31, ob = rr * 64 + cc * 2; return st * 1024 + (ob ^ (((ob >> 9) & 1) << 5)); }
__host__ __device__ __forceinline__ void stage_rc(int b, int& R, int& C) { const int st = b / 1024, sb = b % 1024, swz = sb ^ (((sb >> 9) & 1) << 5); R = (st >> 1) * 16 + swz / 64; C = (st & 1) * 32 + (swz % 64) / 2; }
__host__ __device__ __forceinline__ int perm32(int rho) { const int n = rho >> 4, i = rho & 15; return 8 * (i >> 2) + 4 * n + (i & 3); }

struct Unit { int pm, pn; };
struct Gemm { const bf16_t* A; const bf16_t* Bt; int M, N, K; };

struct StaticOrder {
    int nM, nN, nwg, G, c;
    __host__ __device__ void init(int M, int N, int G_, int c_) { nM = M / BM; nN = N / BM; nwg = nM * nN; G = G_; c = c_; }
    __host__ __device__ bool next(int i, Unit& u) const {
        const long L = (long)i * G + c; if (L >= nwg) return false;
        int wgid = (int)L; { const int q = nwg / NXCD, r = nwg % NXCD, xcd = wgid % NXCD, off = wgid / NXCD; wgid = (xcd < r ? xcd * (q + 1) : r * (q + 1) + (xcd - r) * q) + off; }
        const int nig = WGM * nN, gid = wgid / nig, fm = gid * WGM, gsz = (nM - fm) < WGM ? (nM - fm) : WGM;
        u.pm = fm + ((wgid % nig) % gsz); u.pn = (wgid % nig) / gsz; return true;
    }
    __device__ __forceinline__ void a_ready(const Unit&) const {}
    __device__ __forceinline__ void done(const Unit&) const {}
};

__device__ __forceinline__ unsigned cvt_pk_bf16(float lo, float hi) { unsigned r; asm volatile("v_cvt_pk_bf16_f32 %0, %1, %2" : "=v"(r) : "v"(lo), "v"(hi)); return r; }
typedef float f32x2 __attribute__((ext_vector_type(2)));
__device__ __forceinline__ f32x2 gelu_pk(f32x2 v) {
    const f32x2 av = __builtin_elementwise_abs(v), d = av * 0.2316418882f + 1.0f;
    f32x2 t; t.x = __builtin_amdgcn_rcpf(d.x); t.y = __builtin_amdgcn_rcpf(d.y);
    f32x2 q = t * 0.5307027145f + (-0.7265760135f); q = q * t + 0.7107068705f; q = q * t + (-0.142248368f); q = q * t + 0.127414796f; q = q * t;
    const f32x2 s = (v * v) * (-0.72134752044f);
    f32x2 e; e.x = __builtin_amdgcn_exp2f(s.x); e.y = __builtin_amdgcn_exp2f(s.y);
    const f32x2 m = v * (q * e), r = v - m;
    f32x2 o; o.x = v.x < 0.f ? m.x : r.x; o.y = v.y < 0.f ? m.y : r.y; return o;
}


struct EpiProj {
    static constexpr bool PERM = true, AFTER_DRAIN = false;
    bf16_t* O; int ldc; int gelu_from_pn;
    __device__ __forceinline__ void operator()(const f32x4 (&acc)[2][2][4][2], const Unit& u, int wr, int wc, int fr, int fq) const {
        const int row0 = u.pm * BM + wr * 64 + fr; const int col0 = u.pn * BM + wc * 32 + 8 * fq;
        const bool act = u.pn >= gelu_from_pn;
#pragma unroll
        for (int ai = 0; ai < 2; ++ai)
#pragma unroll
            for (int m = 0; m < 4; ++m) { bf16_t* rowp = O + (size_t)(row0 + ai * HALF + m * 16) * ldc + col0;
#pragma unroll
                for (int bj = 0; bj < 2; ++bj) { f32x4 v0 = acc[ai][bj][m][0], v1 = acc[ai][bj][m][1];
                    if (act) { f32x2 a = gelu_pk((f32x2){v0[0], v0[1]}), b = gelu_pk((f32x2){v0[2], v0[3]}), c = gelu_pk((f32x2){v1[0], v1[1]}), d = gelu_pk((f32x2){v1[2], v1[3]});
                        v0 = (f32x4){a.x, a.y, b.x, b.y}; v1 = (f32x4){c.x, c.y, d.x, d.y}; }
                    u32x4 w; w.x = cvt_pk_bf16(v0[0], v0[1]); w.y = cvt_pk_bf16(v0[2], v0[3]); w.z = cvt_pk_bf16(v1[0], v1[1]); w.w = cvt_pk_bf16(v1[2], v1[3]);
                    *(u32x4*)(rowp + bj * HALF) = w; } }
    }
};
struct EpiH {
    static constexpr bool PERM = false, AFTER_DRAIN = false;
    const float* X; bf16_t* HB; float* sumsq; int ldc;
    __device__ __forceinline__ void operator()(const f32x4 (&acc)[2][2][4][2], const Unit& u, int wr, int wc, int fr, int fq) const {
        const int col0 = u.pn * BM + wc * 32 + 4 * fq;
        f32x4 xa[4][2][2];
#pragma unroll
        for (int m = 0; m < 4; ++m) { const size_t off = (size_t)(u.pm * BM + wr * 64 + m * 16 + fr) * ldc + col0;
#pragma unroll
            for (int bj = 0; bj < 2; ++bj)
#pragma unroll
                for (int n = 0; n < 2; ++n) xa[m][bj][n] = *(const f32x4*)(X + off + bj * HALF + n * 16); }
#pragma unroll
        for (int ai = 0; ai < 2; ++ai)
#pragma unroll
            for (int m = 0; m < 4; ++m) { const int r = u.pm * BM + ai * HALF + wr * 64 + m * 16 + fr; const size_t off = (size_t)r * ldc + col0; float ss = 0.f;
                f32x4 h[2][2];
#pragma unroll
                for (int bj = 0; bj < 2; ++bj)
#pragma unroll
                    for (int n = 0; n < 2; ++n) h[bj][n] = xa[m][bj][n] + acc[ai][bj][m][n];
                if (ai == 0) {
#pragma unroll
                    for (int bj = 0; bj < 2; ++bj)
#pragma unroll
                        for (int n = 0; n < 2; ++n) xa[m][bj][n] = *(const f32x4*)(X + off + (size_t)HALF * ldc + bj * HALF + n * 16); }
#pragma unroll
                for (int bj = 0; bj < 2; ++bj)
#pragma unroll
                    for (int n = 0; n < 2; ++n) { const f32x4 hv = h[bj][n];
                        ss += (hv[0] * hv[0] + hv[1] * hv[1]) + (hv[2] * hv[2] + hv[3] * hv[3]);
                        unsigned w0 = cvt_pk_bf16(hv[0], hv[1]), w1 = cvt_pk_bf16(hv[2], hv[3]);
                        typedef unsigned u32x2 __attribute__((ext_vector_type(2))); *(u32x2*)(HB + off + bj * HALF + n * 16) = (u32x2){w0, w1}; }
                ss += __shfl_xor(ss, 16); ss += __shfl_xor(ss, 32);
                if (fq == 0) atomicAdd(sumsq + r, ss); }
    }
};
struct EpiQ {
    static constexpr bool PERM = true, AFTER_DRAIN = false;
    bf16_t* O; int ldc; const float* sumsq; float inv_d, eps;
    __device__ __forceinline__ void operator()(const f32x4 (&acc)[2][2][4][2], const Unit& u, int wr, int wc, int fr, int fq) const {
        const int row0 = u.pm * BM + wr * 64 + fr; const int col0 = u.pn * BM + wc * 32 + 8 * fq;
#pragma unroll
        for (int ai = 0; ai < 2; ++ai)
#pragma unroll
            for (int m = 0; m < 4; ++m) { const int r = row0 + ai * HALF + m * 16; bf16_t* rowp = O + (size_t)r * ldc + col0;
                const float sc = __builtin_amdgcn_rsqf(sumsq[r] * inv_d + eps);
#pragma unroll
                for (int bj = 0; bj < 2; ++bj) { const f32x4 v0 = acc[ai][bj][m][0] * sc, v1 = acc[ai][bj][m][1] * sc;
                    u32x4 w; w.x = cvt_pk_bf16(v0[0], v0[1]); w.y = cvt_pk_bf16(v0[2], v0[3]); w.z = cvt_pk_bf16(v1[0], v1[1]); w.w = cvt_pk_bf16(v1[2], v1[3]);
                    *(u32x4*)(rowp + bj * HALF) = w; } }
    }
};
template <class Epi, class Sched, bool ALIGN_EPI = false, bool SP2 = false>
__device__ __forceinline__ void gemm_phase(PG8_LAS unsigned char* lds, const Gemm g, const Sched& S, const Epi& E) {
    const int tid = threadIdx.x, wid = __builtin_amdgcn_readfirstlane(tid >> 6), lane = tid & 63, wr = wid >> 2, wc = wid & 3, fr = lane & 15, fq = lane >> 4;
    const int K = g.K, nt = K / BK;
    unsigned voffA[2], voffB[2];
#pragma unroll
    for (int i = 0; i < 2; ++i) { int R, C; stage_rc(tid * 16 + i * 8192, R, C); const int Rb = Epi::PERM ? ((R & ~31) + perm32(R & 31)) : R;
        voffA[i] = (unsigned)(R * K + C) * 2u; voffB[i] = (unsigned)(Rb * K + C) * 2u; }
    const size_t kstep = (size_t)(BK * 2);
    const size_t hstep = (size_t)HALF * K * 2;
    const size_t tstep = 2 * hstep;
    const unsigned ldsw = (unsigned)wid * 1024u;
    const int aoff = lds_byte(wr * 64 + fr, fq * 8), boff = lds_byte(wc * 32 + fr, fq * 8);
#define PG8_SA(b, h) (((b) * 2 + (h)) * HTB)
#define PG8_SB(b, h) ((4 + (b) * 2 + (h)) * HTB)
#define PG8_STAGE(bufoff, gbase, voff) do { _Pragma("unroll") for (int _i = 0; _i < 2; ++_i) \
        __builtin_amdgcn_global_load_lds((const unsigned*)((const char*)(gbase) + (voff)[_i]), (PG8_LAS unsigned*)(lds + (bufoff) + ldsw + _i * 8192), 16, 0, 0); } while (0)
#define PG8_LDA(dst, b, h) do { _Pragma("unroll") for (int m = 0; m < 4; ++m) _Pragma("unroll") for (int k = 0; k < 2; ++k) dst[m][k] = *(const PG8_LAS bf16x8*)(lds + PG8_SA(b, h) + aoff + m * 2048 + k * 1024); } while (0)
#define PG8_LDB(dst, b, h) do { _Pragma("unroll") for (int n = 0; n < 2; ++n) _Pragma("unroll") for (int k = 0; k < 2; ++k) dst[n][k] = *(const PG8_LAS bf16x8*)(lds + PG8_SB(b, h) + boff + n * 2048 + k * 1024); } while (0)
#define PG8_MMA(ai, bj, At, Bt) do { __builtin_amdgcn_s_setprio(1); _Pragma("unroll") for (int m = 0; m < 4; ++m) _Pragma("unroll") for (int n = 0; n < 2; ++n) _Pragma("unroll") for (int k = 0; k < 2; ++k) \
        acc[ai][bj][m][n] = __builtin_amdgcn_mfma_f32_16x16x32_bf16(Bt[n][k], At[m][k], acc[ai][bj][m][n], 0, 0, 0); __builtin_amdgcn_s_setprio(0); } while (0)
#define PG8_WAIT_V(n) asm volatile("s_waitcnt vmcnt(" #n ")" ::: "memory")
#define PG8_WAIT_L(n) asm volatile("s_waitcnt lgkmcnt(" #n ")" ::: "memory")
#define PG8_BAR __builtin_amdgcn_s_barrier()
#define PG8_SCHED __builtin_amdgcn_sched_barrier(0)
    Unit cur, nxt; int ui = 0;
    if (!S.next(0, cur)) return;
    f32x4 acc[2][2][4][2];
#pragma unroll
    for (int a = 0; a < 2; ++a)
#pragma unroll
        for (int b = 0; b < 2; ++b)
#pragma unroll
            for (int m = 0; m < 4; ++m)
#pragma unroll
                for (int n = 0; n < 2; ++n) acc[a][b][m][n] = (f32x4){0.f, 0.f, 0.f, 0.f};
    bf16x8 At[4][2], B0[2][2], B1[2][2];
    const char* cA = (const char*)g.A + (size_t)cur.pm * tstep; const char* cB = (const char*)g.Bt + (size_t)cur.pn * tstep;
    S.a_ready(cur);
    if constexpr (SP2) {
        PG8_STAGE(PG8_SB(0, 0), cB, voffB); PG8_STAGE(PG8_SB(0, 1), cB + hstep, voffB); PG8_STAGE(PG8_SA(0, 0), cA, voffA); PG8_STAGE(PG8_SA(0, 1), cA + hstep, voffA);
        if (wr == 1) PG8_BAR;
        PG8_WAIT_V(2); PG8_BAR;
        PG8_STAGE(PG8_SB(1, 0), cB + kstep, voffB); PG8_STAGE(PG8_SA(1, 0), cA + kstep, voffA); PG8_STAGE(PG8_SB(1, 1), cB + hstep + kstep, voffB);
        PG8_WAIT_V(6); PG8_BAR;
    } else {
        PG8_STAGE(PG8_SB(0, 0), cB, voffB); PG8_STAGE(PG8_SA(0, 0), cA, voffA); PG8_STAGE(PG8_SB(0, 1), cB + hstep, voffB); PG8_STAGE(PG8_SA(0, 1), cA + hstep, voffA);
        if (wr == 1) PG8_BAR;
        PG8_WAIT_V(4); PG8_BAR;
        PG8_STAGE(PG8_SB(1, 0), cB + kstep, voffB); PG8_STAGE(PG8_SA(1, 0), cA + kstep, voffA); PG8_STAGE(PG8_SB(1, 1), cB + hstep + kstep, voffB);
        PG8_WAIT_V(6); PG8_BAR;
    }
    for (;;) {
        const bool has_next = S.next(ui + 1, nxt);
        const char* nA = has_next ? (const char*)g.A + (size_t)nxt.pm * tstep : cA; const char* nB = has_next ? (const char*)g.Bt + (size_t)nxt.pn * tstep : cB;
        for (int t = 0; t < nt; t += 2) {
            const bool last = (t == nt - 2);
            const char* a1 = cA + (size_t)(t + 1) * kstep;
            const char* a2 = last ? nA : cA + (size_t)(t + 2) * kstep; const char* b2 = last ? nB : cB + (size_t)(t + 2) * kstep;
            const char* a3 = a2 + kstep; const char* b3 = b2 + kstep;
            if (last && has_next) S.a_ready(nxt);
            if constexpr (SP2) {
            PG8_LDB(B0, 0, 0); PG8_LDB(B1, 0, 1); PG8_SCHED; PG8_LDA(At, 0, 0); PG8_STAGE(PG8_SA(1, 1), a1 + hstep, voffA);
            PG8_WAIT_V(8); PG8_WAIT_L(0); PG8_BAR; PG8_MMA(0, 0, At, B0); PG8_MMA(0, 1, At, B1); PG8_BAR; PG8_SCHED;
            PG8_LDA(At, 0, 1); PG8_STAGE(PG8_SB(0, 0), b2, voffB); PG8_STAGE(PG8_SB(0, 1), b2 + hstep, voffB); PG8_STAGE(PG8_SA(0, 0), a2, voffA);
            PG8_WAIT_V(8); PG8_WAIT_L(0); PG8_BAR; PG8_MMA(1, 0, At, B0); PG8_MMA(1, 1, At, B1); PG8_BAR; PG8_SCHED;
            PG8_LDB(B0, 1, 0); PG8_LDB(B1, 1, 1); PG8_SCHED; PG8_LDA(At, 1, 0); PG8_STAGE(PG8_SA(0, 1), a2 + hstep, voffA);
            PG8_WAIT_V(8); PG8_WAIT_L(0); PG8_BAR; PG8_MMA(0, 0, At, B0); PG8_MMA(0, 1, At, B1); PG8_BAR; PG8_SCHED;
            PG8_LDA(At, 1, 1); PG8_STAGE(PG8_SB(1, 0), b3, voffB); PG8_STAGE(PG8_SB(1, 1), b3 + hstep, voffB); PG8_STAGE(PG8_SA(1, 0), a3, voffA);
            PG8_WAIT_V(8); PG8_WAIT_L(0); PG8_BAR; PG8_MMA(1, 0, At, B0); PG8_MMA(1, 1, At, B1); PG8_BAR; PG8_SCHED;
            } else {
            PG8_LDB(B0, 0, 0); PG8_SCHED; PG8_LDA(At, 0, 0); PG8_STAGE(PG8_SA(1, 1), a1 + hstep, voffA);
            PG8_WAIT_L(8); PG8_BAR; PG8_WAIT_L(0); PG8_MMA(0, 0, At, B0); PG8_BAR; PG8_SCHED;
            PG8_LDB(B1, 0, 1); PG8_STAGE(PG8_SB(0, 0), b2, voffB);
            PG8_BAR; PG8_WAIT_L(0); PG8_MMA(0, 1, At, B1); PG8_BAR;
            PG8_LDA(At, 0, 1); PG8_STAGE(PG8_SA(0, 0), a2, voffA);
            PG8_BAR; PG8_WAIT_L(0); PG8_MMA(1, 0, At, B0); PG8_BAR; PG8_SCHED;
            PG8_STAGE(PG8_SB(0, 1), b2 + hstep, voffB);
            PG8_WAIT_V(6); PG8_BAR; PG8_MMA(1, 1, At, B1); PG8_BAR;
            PG8_LDB(B0, 1, 0); PG8_SCHED; PG8_LDA(At, 1, 0); PG8_STAGE(PG8_SA(0, 1), a2 + hstep, voffA);
            PG8_WAIT_L(8); PG8_BAR; PG8_WAIT_L(0); PG8_MMA(0, 0, At, B0); PG8_BAR; PG8_SCHED;
            PG8_LDB(B1, 1, 1); PG8_STAGE(PG8_SB(1, 0), b3, voffB);
            PG8_BAR; PG8_WAIT_L(0); PG8_MMA(0, 1, At, B1); PG8_BAR;
            PG8_LDA(At, 1, 1); PG8_STAGE(PG8_SA(1, 0), a3, voffA);
            PG8_BAR; PG8_WAIT_L(0); PG8_MMA(1, 0, At, B0); PG8_BAR; PG8_SCHED;
            PG8_STAGE(PG8_SB(1, 1), b3 + hstep, voffB);
            PG8_WAIT_V(6); PG8_BAR; PG8_MMA(1, 1, At, B1); PG8_BAR;
            }
        }
        if constexpr (ALIGN_EPI) { if (wr == 0) PG8_BAR; }
        if constexpr (!Epi::AFTER_DRAIN) { E(acc, cur, wr, wc, fr, fq); S.done(cur); }
        if (!has_next) break;
#pragma unroll
        for (int a = 0; a < 2; ++a)
#pragma unroll
            for (int b = 0; b < 2; ++b)
#pragma unroll
                for (int m = 0; m < 4; ++m)
#pragma unroll
                    for (int n = 0; n < 2; ++n) acc[a][b][m][n] = (f32x4){0.f, 0.f, 0.f, 0.f};
        cur = nxt; cA = nA; cB = nB; ++ui;
        if constexpr (ALIGN_EPI) { if (wr == 1) PG8_BAR; }
    }
    PG8_WAIT_V(0);
    if constexpr (!ALIGN_EPI) { if (wr == 0) PG8_BAR; }
    PG8_BAR;
    if constexpr (Epi::AFTER_DRAIN) { E.fused(acc, cur, wr, wc, fr, fq, lds, wid, lane); S.done(cur); }
#undef PG8_SA
#undef PG8_SB
#undef PG8_STAGE
#undef PG8_LDA
#undef PG8_LDB
#undef PG8_MMA
#undef PG8_WAIT_V
#undef PG8_WAIT_L
#undef PG8_BAR
#undef PG8_SCHED
}
}

constexpr int NWAVES = 8;
constexpr int M = 16384, D = 1024, DIN = 2560, CW = 512, SW = 512, NQ = 2048, NEXP = 16384, NH = 8, TOPK = 16, NSEL = NH * TOPK;
constexpr int C_B = 0, C_C = 512, C_H = 1024, C_U = 1536, C_V = 2048;
constexpr float EPS = 1e-6f;
constexpr size_t MiB = 1u << 20;
constexpr size_t WS_CTL = 0, CTL_ZERO_BYTES = 128 * 1024;
constexpr size_t WS_WIN = 1 * MiB, WS_WOUT = 6 * MiB, WS_WQ = 8 * MiB, WS_KEYS = 12 * MiB, WS_SGUW = 12 * MiB + 512 * 1024;
constexpr size_t WS_U8 = 16 * MiB, WS_V8 = 32 * MiB, WS_SU = 48 * MiB, WS_SV = 48 * MiB + 65536;
constexpr size_t WS_XN = 80 * MiB, WS_Y = 80 * MiB;
constexpr size_t WS_PROJ = 112 * MiB, WS_Q = 112 * MiB;
constexpr size_t WS_HB = 192 * MiB, WS_IDX = 224 * MiB, WS_GATE = 232 * MiB, WS_END = 240 * MiB;
constexpr int CW_BAR = 4096;
constexpr int CW_SUMSQ = 8192;
static_assert(WS_V8 == WS_U8 + (size_t)NEXP * D && WS_SV == WS_SU + (size_t)NEXP * 4, "table map");
static_assert(CW_BAR + 3456 <= CW_SUMSQ && (CW_SUMSQ + M) * 4 <= (int)CTL_ZERO_BYTES, "ctl");
constexpr int RING_BYTES = 131072, LDSCTL_OFF = RING_BYTES, MISC_OFF = LDSCTL_OFF + 320, LDS_BYTES = 147456;

#define GAS __attribute__((address_space(1)))
#define LAS __attribute__((address_space(3)))
typedef unsigned short bf16;
typedef unsigned v4u __attribute__((ext_vector_type(4)));
typedef unsigned v2u __attribute__((ext_vector_type(2)));
typedef float f32x4 __attribute__((ext_vector_type(4)));
typedef float f32x16 __attribute__((ext_vector_type(16)));
typedef short bf16x8 __attribute__((ext_vector_type(8)));
typedef __bf16 bf16x2v __attribute__((ext_vector_type(2)));
typedef float f32x2 __attribute__((ext_vector_type(2)));
typedef GAS unsigned gu32;
#define RLX_AGENT __ATOMIC_RELAXED, __HIP_MEMORY_SCOPE_AGENT
#define LDS_WAIT() asm volatile("s_waitcnt lgkmcnt(0)" ::: "memory")
#define VM_WAIT() asm volatile("s_waitcnt vmcnt(0)" ::: "memory")
__device__ __forceinline__ unsigned f2bf(float f) { unsigned u = __builtin_bit_cast(unsigned, f); return (u + 0x7fffu + ((u >> 16) & 1u)) >> 16; }
__device__ __forceinline__ unsigned pk2(float lo, float hi) { return f2bf(lo) | (f2bf(hi) << 16); }
__device__ __forceinline__ float bflo(unsigned w) { return __builtin_bit_cast(float, w << 16); }
__device__ __forceinline__ float bfhi(unsigned w) { return __builtin_bit_cast(float, w & 0xffff0000u); }
__device__ __forceinline__ float bf2f(bf16 b) { return __builtin_bit_cast(float, (unsigned)b << 16); }
__device__ __forceinline__ float wave_sum(float v) {
#pragma unroll
    for (int o = 1; o < 64; o <<= 1) v += __shfl_xor(v, o);
    return v;
}
__device__ __forceinline__ float gelu_exact(float v) { return 0.5f * v * (1.0f + erff(v * 0.70710678118654752f)); }
#define XB_TMO      128
#define XB_XCNT(j)  (256  + 64 * (j))
#define XB_XSUB(j)  (1280 + 64 * (j))
#define XB_XGEN(j)  (2304 + 64 * (j))
#define XB_TOP      3328
#define XB_TOPGEN   3392
#define XCD_BAR_WORDS 3456
#define XB_SPIN_CAP (1u << 18)

__device__ __forceinline__ unsigned xb_ld(unsigned* p)              { return __hip_atomic_load(p, __ATOMIC_RELAXED, __HIP_MEMORY_SCOPE_AGENT); }
__device__ __forceinline__ unsigned xb_add(unsigned* p, unsigned v) { return __hip_atomic_fetch_add(p, v, __ATOMIC_RELAXED, __HIP_MEMORY_SCOPE_AGENT); }
__device__ __forceinline__ unsigned xb_xcc_id() { return (unsigned)__builtin_amdgcn_s_getreg((3 << 11) | 20) & 0xFu; }
#define XB_SPIN(cond, bar) do { unsigned _sp = 0; while (cond) { __builtin_amdgcn_s_sleep(1); \
    if ((++_sp & 255u) == 0u) { if (xb_ld(&(bar)[XB_TMO])) break; if (_sp > XB_SPIN_CAP) { atomicAdd(&(bar)[XB_TMO], 1u); break; } } } } while (0)

struct XcdBarrier {
    unsigned* bar; unsigned x;
    volatile LAS unsigned* st;
};

__device__ __forceinline__ XcdBarrier xcd_barrier_post(unsigned* bar, volatile LAS unsigned* st) {
    XcdBarrier b; b.bar = bar; b.x = xb_xcc_id(); b.st = st;
    if (threadIdx.x == 0) (void)xb_add(&bar[XB_XCNT(b.x)], 1u);
    return b;
}
__device__ __forceinline__ void xcd_barrier_complete(unsigned* bar, unsigned x, unsigned& nloc, unsigned& nx) {
    const unsigned G = gridDim.x * gridDim.y * gridDim.z;
    unsigned sum, cnt, mine, sp = 0u;
    for (;;) {
        sum = 0u; cnt = 0u; mine = 0u;
#pragma unroll
        for (unsigned j = 0; j < 16; ++j) { const unsigned c = xb_ld(&bar[XB_XCNT(j)]); sum += c; cnt += (c > 0u) ? 1u : 0u; mine = (j == x) ? c : mine; }
        if (sum == G) break;
        __builtin_amdgcn_s_sleep(1);
        if ((++sp & 255u) == 0u) { if (xb_ld(&bar[XB_TMO])) break; if (sp > XB_SPIN_CAP) { atomicAdd(&bar[XB_TMO], 1u); break; } }
    }
    nloc = mine > 0u ? mine : 1u; nx = cnt > 0u ? cnt : 1u;
}

__device__ __forceinline__ void xcd_barrier(const XcdBarrier& b) {
    asm volatile("s_waitcnt vmcnt(0)" ::: "memory");
    __syncthreads();
    if (threadIdx.x == 0) {
        unsigned* bar = b.bar;
        __builtin_amdgcn_s_waitcnt(0);
        unsigned nloc = b.st[0], nx = b.st[1];
        if (nloc == 0u) { xcd_barrier_complete(bar, b.x, nloc, nx); b.st[0] = nloc; b.st[1] = nx; }
        const unsigned old = xb_add(&bar[XB_XSUB(b.x)], 1u);
        const unsigned gen = old / nloc;
        if (old + 1u == (gen + 1u) * nloc) {
            __builtin_amdgcn_fence(__ATOMIC_RELEASE, "agent");
            asm volatile("s_waitcnt vmcnt(0)" ::: "memory");
            const unsigned og = xb_add(&bar[XB_TOP], 1u);
            const unsigned tg = og / nx;
            if (og + 1u == (tg + 1u) * nx) xb_add(&bar[XB_TOPGEN], 1u);
            else XB_SPIN(xb_ld(&bar[XB_TOPGEN]) == tg, bar);
            __builtin_amdgcn_fence(__ATOMIC_ACQUIRE, "agent");
            xb_add(&bar[XB_XGEN(b.x)], 1u);
            asm volatile("s_waitcnt vmcnt(0)" ::: "memory");
        } else {
            XB_SPIN(xb_ld(&bar[XB_XGEN(b.x)]) == gen, bar);
            __builtin_amdgcn_fence(__ATOMIC_ACQUIRE, "agent");
            asm volatile("s_waitcnt vmcnt(0)" ::: "memory");
        }
    }
    __syncthreads();
}

struct Frame {
    LAS unsigned char* lds;
    volatile LAS unsigned* MISC;
    gu32* ctl;
    int tid, lane, wave, vcu, G, gw, NGW;
    const float *x, *attn_g, *w_in, *conv_w, *sgu_w, *sgu_b, *sgu_norm_g, *onc_g, *ons_g, *w_out, *ffn_g, *w_q, *sub_keys, *peer_u, *peer_v, *final_g;
    float* out;
    bf16 *WinT, *WoutT, *WqT, *KEYS, *SGUW, *XN, *Y, *PROJ, *Q, *HB;
    unsigned char *U8, *V8; float *SU, *SV;
    int* IDX; float* GATE; float* sumsq;
};
__device__ __forceinline__ void frame_ptrs(Frame& F, const float* const* in, float* out, unsigned char* ws) {
    F.x = in[0]; F.attn_g = in[1]; F.w_in = in[2]; F.conv_w = in[3]; F.sgu_w = in[4]; F.sgu_b = in[5]; F.sgu_norm_g = in[6]; F.onc_g = in[7]; F.ons_g = in[8];
    F.w_out = in[9]; F.ffn_g = in[10]; F.w_q = in[11]; F.sub_keys = in[12]; F.peer_u = in[13]; F.peer_v = in[14]; F.final_g = in[15]; F.out = out;
    F.ctl = (gu32*)(ws + WS_CTL);
    F.WinT = (bf16*)(ws + WS_WIN); F.WoutT = (bf16*)(ws + WS_WOUT); F.WqT = (bf16*)(ws + WS_WQ); F.KEYS = (bf16*)(ws + WS_KEYS); F.SGUW = (bf16*)(ws + WS_SGUW);
    F.U8 = ws + WS_U8; F.V8 = ws + WS_V8; F.SU = (float*)(ws + WS_SU); F.SV = (float*)(ws + WS_SV); F.XN = (bf16*)(ws + WS_XN); F.Y = (bf16*)(ws + WS_Y); F.PROJ = (bf16*)(ws + WS_PROJ); F.Q = (bf16*)(ws + WS_Q);
    F.HB = (bf16*)(ws + WS_HB); F.IDX = (int*)(ws + WS_IDX); F.GATE = (float*)(ws + WS_GATE); F.sumsq = (float*)(ws + WS_CTL) + CW_SUMSQ;
}

__device__ __forceinline__ void p0_transpose_item(const float* W, int K, int N, bf16* WT, LAS float* scr, int item, int lane, const float* rowscale = nullptr) {
    const int nblk = N / 32, kb = item / nblk, nb = item % nblk, k0 = 64 * kb, n0 = 32 * nb;
#pragma unroll 8
    for (int i = 0; i < 32; ++i) { const int kk = 2 * i + (lane >> 5); scr[kk * 33 + (lane & 31)] = W[(size_t)(k0 + kk) * N + n0 + (lane & 31)] * (rowscale ? rowscale[k0 + kk] : 1.0f); }
    LDS_WAIT(); asm volatile("" ::: "memory");
    const int c = lane & 7;
#pragma unroll
    for (int j = 0; j < 4; ++j) { const int n = (lane >> 3) + 8 * j; const LAS float* s = scr + (8 * c) * 33 + n;
        v4u o; o.x = pk2(s[0 * 33], s[1 * 33]); o.y = pk2(s[2 * 33], s[3 * 33]); o.z = pk2(s[4 * 33], s[5 * 33]); o.w = pk2(s[6 * 33], s[7 * 33]);
        *(v4u*)(WT + (size_t)(n0 + n) * K + k0 + 8 * c) = o; }
    LDS_WAIT(); asm volatile("" ::: "memory");
}
__device__ __forceinline__ v4u cvt8(const float* p) { const f32x4 a = *(const f32x4*)p, b = *(const f32x4*)(p + 4); v4u o; o.x = pk2(a[0], a[1]); o.y = pk2(a[2], a[3]); o.z = pk2(b[0], b[1]); o.w = pk2(b[2], b[3]); return o; }
__device__ __forceinline__ unsigned pack_i8(float a, float b, float c, float d) {
    const int ia = (int)rintf(a), ib = (int)rintf(b), ic = (int)rintf(c), id = (int)rintf(d);
    return ((unsigned)ia & 0xffu) | (((unsigned)ib & 0xffu) << 8) | (((unsigned)ic & 0xffu) << 16) | ((unsigned)id << 24);
}
__device__ __forceinline__ void convert_tables(Frame& F, int cw, int ncw, int row_lo, int row_hi) {
    const int lane = F.lane;
    constexpr int RB = 4;
    for (int r0 = row_lo + cw * RB; r0 < row_hi; r0 += ncw * RB) {
        f32x4 v[RB][4];
#pragma unroll
        for (int q = 0; q < RB; ++q) { const int rrow = r0 + q; const bool second = rrow >= NEXP; const int e = second ? rrow - NEXP : rrow;
            const f32x4* src = (const f32x4*)((second ? F.peer_v : F.peer_u) + (size_t)e * D) + lane;
#pragma unroll
            for (int j = 0; j < 4; ++j) v[q][j] = src[64 * j]; }
#pragma unroll
        for (int q = 0; q < RB; ++q) { const int rrow = r0 + q; const bool second = rrow >= NEXP; const int e = second ? rrow - NEXP : rrow;
            float mx = 0.f;
#pragma unroll
            for (int j = 0; j < 4; ++j) mx = fmaxf(fmaxf(mx, fmaxf(fabsf(v[q][j][0]), fabsf(v[q][j][1]))), fmaxf(fabsf(v[q][j][2]), fabsf(v[q][j][3])));
#pragma unroll
            for (int o = 1; o < 64; o <<= 1) mx = fmaxf(mx, __shfl_xor(mx, o));
            const float top = second ? 6.f : 127.f;
            const float sc = mx > 0.f ? top / mx : 1.f, inv = mx > 0.f ? mx / top : 1.f;
            unsigned* dst = (unsigned*)(F.U8 + (size_t)rrow * D) + lane;
            if (second) {
                unsigned short* d4 = (unsigned short*)(F.V8 + (size_t)e * (D / 2)) + lane;
#pragma unroll
                for (int j = 0; j < 4; ++j) { unsigned w = 0u; w = __builtin_amdgcn_cvt_scalef32_pk_fp4_f32(w, v[q][j][0] * sc, v[q][j][1] * sc, 1.0f, 0); w = __builtin_amdgcn_cvt_scalef32_pk_fp4_f32(w, v[q][j][2] * sc, v[q][j][3] * sc, 1.0f, 1); d4[64 * j] = (unsigned short)w; }
            } else {
#pragma unroll
                for (int j = 0; j < 4; ++j) dst[64 * j] = pack_i8(v[q][j][0] * sc, v[q][j][1] * sc, v[q][j][2] * sc, v[q][j][3] * sc);
            }
            if (lane == 0) F.SU[rrow] = inv;
        }
    }
}

__device__ __forceinline__ void late_weights(Frame& F, int cw, int ncw) {
    LAS float* scr = (LAS float*)(F.lds + F.wave * 16384);
    const int lane = F.lane;
    constexpr int I_OUT = (D / 64) * (D / 32), I_Q = (D / 64) * (NQ / 32);
    for (int it = cw; it < I_OUT + I_Q; it += ncw) {
        if (it < I_OUT) p0_transpose_item(F.w_out, D, D, F.WoutT, scr, it, lane);
        else p0_transpose_item(F.w_q, D, NQ, F.WqT, scr, it - I_OUT, lane, F.ffn_g);
    }
    for (int i = cw * 64 + lane; i < 262144 / 8; i += ncw * 64) *(v4u*)(F.KEYS + (size_t)i * 8) = cvt8(F.sub_keys + (size_t)i * 8);
}
__device__ __forceinline__ void p0_prologue(Frame& F) {
    LAS float* scr = (LAS float*)(F.lds + F.wave * 16384);
    const int gw = F.gw, NGW = F.NGW, lane = F.lane;
    constexpr int I_IN = (D / 64) * (DIN / 32);
    for (int it = gw; it < I_IN; it += NGW) p0_transpose_item(F.w_in, D, DIN, F.WinT, scr, it, lane);
    for (int i = gw * 64 + lane; i < 65536 / 8; i += NGW * 64) {
        const int e = i * 8, ii = (e >> 7) & 127, jj = e & 127; v4u o = cvt8(F.sgu_w + e); if ((ii >> 6) < (jj >> 6)) o = (v4u){0u, 0u, 0u, 0u}; *(v4u*)(F.SGUW + e) = o;
    }
    for (int m0 = gw * 4; m0 < M; m0 += NGW * 4) {
        f32x4 v[4][4];
#pragma unroll
        for (int q = 0; q < 4; ++q) { const f32x4* xr = (const f32x4*)(F.x + (size_t)(m0 + q) * D) + lane;
#pragma unroll
            for (int j = 0; j < 4; ++j) v[q][j] = xr[64 * j]; }
#pragma unroll
        for (int q = 0; q < 4; ++q) { float s = 0.f;
#pragma unroll
            for (int j = 0; j < 4; ++j) s += (v[q][j][0] * v[q][j][0] + v[q][j][1] * v[q][j][1]) + (v[q][j][2] * v[q][j][2] + v[q][j][3] * v[q][j][3]);
            const float rstd = __builtin_amdgcn_rsqf(wave_sum(s) * (1.f / D) + EPS);
            v2u* o8 = (v2u*)(F.XN + (size_t)(m0 + q) * D) + lane;
#pragma unroll
            for (int j = 0; j < 4; ++j) { const f32x4 g = *((const f32x4*)F.attn_g + lane + 64 * j); const f32x4 y = v[q][j] * rstd * g; o8[64 * j] = (v2u){pk2(y[0], y[1]), pk2(y[2], y[3])}; } }
    }
}

template <int NU> __device__ __forceinline__ void sgu_units(Frame& F, const int (&nbs)[2], int g, bool load_w) {
    LAS unsigned char* WmL = F.lds + 2 * 34816;
    const int tid = F.tid, lane = F.lane, w = F.wave, fr = lane & 15, fq = lane >> 4;
    v2u uu8[NU][8];
#pragma unroll
    for (int q2 = 0; q2 < NU; ++q2) { const bf16* up = F.PROJ + (size_t)(nbs[q2] * 128 + 16 * w + fr) * DIN + C_U + g * 128 + 4 * fq;
#pragma unroll
        for (int mt = 0; mt < 8; ++mt) uu8[q2][mt] = *(const v2u*)(up + 16 * mt); }
    v4u rr[NU][4];
    { const int j = tid >> 2, q = tid & 3;
#pragma unroll
      for (int q2 = 0; q2 < NU; ++q2) { const v4u* src = (const v4u*)(F.PROJ + (size_t)(nbs[q2] * 128 + j) * DIN + C_V + g * 128 + 32 * q);
#pragma unroll
          for (int i = 0; i < 4; ++i) rr[q2][i] = src[i]; } }
    if (load_w) {
        const int row = tid >> 2;
#pragma unroll
        for (int c = 0; c < 4; ++c) { const int chunk = (tid & 3) + 4 * c; *(LAS v4u*)(WmL + row * 272 + chunk * 16) = *(const v4u*)(F.SGUW + (size_t)(g * 128 + row) * 128 + chunk * 8); }
    }
#pragma unroll
    for (int q2 = 0; q2 < NU; ++q2) {
        LAS unsigned char* VnT = F.lds + q2 * 34816;
        const int j = tid >> 2, q = tid & 3;
        float v[32]; float ss = 0.f;
#pragma unroll
        for (int i = 0; i < 4; ++i) { v[8 * i + 0] = bflo(rr[q2][i].x); v[8 * i + 1] = bfhi(rr[q2][i].x); v[8 * i + 2] = bflo(rr[q2][i].y); v[8 * i + 3] = bfhi(rr[q2][i].y);
            v[8 * i + 4] = bflo(rr[q2][i].z); v[8 * i + 5] = bfhi(rr[q2][i].z); v[8 * i + 6] = bflo(rr[q2][i].w); v[8 * i + 7] = bfhi(rr[q2][i].w); }
#pragma unroll
        for (int i = 0; i < 32; ++i) ss += v[i] * v[i];
        ss += __shfl_xor(ss, 1); ss += __shfl_xor(ss, 2);
        const float rstd = __builtin_amdgcn_rsqf(ss * (1.f / 128.f) + EPS);
        const float* gvp = F.sgu_norm_g + g * 128 + 32 * q;
#pragma unroll
        for (int i = 0; i < 32; ++i) *(LAS bf16*)(VnT + (32 * q + i) * 272 + j * 2) = (bf16)f2bf(v[i] * rstd * gvp[i]);
    }
    __syncthreads();
#pragma unroll
    for (int q2 = 0; q2 < NU; ++q2) {
        LAS unsigned char* VnT = F.lds + q2 * 34816;
        f32x4 acc[8];
#pragma unroll
        for (int mt = 0; mt < 8; ++mt) acc[mt] = (f32x4){0.f, 0.f, 0.f, 0.f};
        const int nks = (w < 4) ? 2 : 4;
#pragma unroll
        for (int ks = 0; ks < 4; ++ks) if (ks < nks) {
            const bf16x8 b = *(const LAS bf16x8*)(WmL + (16 * w + fr) * 272 + (32 * ks + 8 * fq) * 2);
#pragma unroll
            for (int mt = 0; mt < 8; ++mt) { const bf16x8 a = *(const LAS bf16x8*)(VnT + (16 * mt + fr) * 272 + (32 * ks + 8 * fq) * 2);
                acc[mt] = __builtin_amdgcn_mfma_f32_16x16x32_bf16(a, b, acc[mt], 0, 0, 0); }
        }
        const int i = 16 * w + fr, t = nbs[q2] * 128 + i;
        const float bias = F.sgu_b[g * 128 + i];
        float yv[8][4]; float ss = 0.f;
#pragma unroll
        for (int mt = 0; mt < 8; ++mt) { const v2u uu = uu8[q2][mt];
            yv[mt][0] = bflo(uu.x) * (acc[mt][0] + bias); yv[mt][1] = bfhi(uu.x) * (acc[mt][1] + bias); yv[mt][2] = bflo(uu.y) * (acc[mt][2] + bias); yv[mt][3] = bfhi(uu.y) * (acc[mt][3] + bias);
            ss += (yv[mt][0] * yv[mt][0] + yv[mt][1] * yv[mt][1]) + (yv[mt][2] * yv[mt][2] + yv[mt][3] * yv[mt][3]); }
        ss += __shfl_xor(ss, 16); ss += __shfl_xor(ss, 32);
        const float rstd = __builtin_amdgcn_rsqf(ss * (1.f / 128.f) + EPS);
        const float* gop = F.ons_g + g * 128 + 4 * fq; bf16* yp = F.Y + (size_t)t * D + CW + g * 128 + 4 * fq;
#pragma unroll
        for (int mt = 0; mt < 8; ++mt) { const f32x4 gg = *(const f32x4*)(gop + 16 * mt);
            *(v2u*)(yp + 16 * mt) = (v2u){pk2(yv[mt][0] * rstd * gg[0], yv[mt][1] * rstd * gg[1]), pk2(yv[mt][2] * rstd * gg[2], yv[mt][3] * rstd * gg[3])}; }
    }
    __syncthreads();
}
__device__ __forceinline__ void p2_mixer(Frame& F) {
    const int lane = F.lane;
    {
        const int NUNIT = (M / 128) * 4; int loaded_g = -1; int u = blockIdx.x;
        if (F.G % 4 == 0) for (; u + F.G < NUNIT; u += 2 * F.G) { const int nbs[2] = {u >> 2, (u + F.G) >> 2}; const int g = u & 3; sgu_units<2>(F, nbs, g, loaded_g != g); loaded_g = g; }
        for (; u < NUNIT; u += F.G) { const int nbs[2] = {u >> 2, u >> 2}; const int g = u & 3; sgu_units<1>(F, nbs, g, loaded_g != g); loaded_g = g; }
    }
    for (int cu = F.gw; cu < M / 8; cu += F.NGW) {
        const int t0 = cu * 8, c0 = 8 * lane;
        v4u cb[10], hbv[10];
#pragma unroll
        for (int k = 0; k < 10; ++k) { const int tr = t0 - 2 + k; const bf16* row = F.PROJ + (size_t)(tr < 0 ? 0 : tr) * DIN; cb[k] = *(const v4u*)(row + C_C + c0); hbv[k] = *(const v4u*)(row + C_H + c0); }
        float w0[8], w1[8], w2[8], go[8];
#pragma unroll
        for (int i = 0; i < 8; ++i) { w0[i] = F.conv_w[c0 + i]; w1[i] = F.conv_w[CW + c0 + i]; w2[i] = F.conv_w[2 * CW + c0 + i]; go[i] = F.onc_g[c0 + i]; }
        float z1[8], z2[8];
#pragma unroll
        for (int k = 0; k < 10; ++k) {
            const v4u c = cb[k], h = hbv[k]; float z[8];
            z[0] = bflo(c.x) * bflo(h.x); z[1] = bfhi(c.x) * bfhi(h.x); z[2] = bflo(c.y) * bflo(h.y); z[3] = bfhi(c.y) * bfhi(h.y);
            z[4] = bflo(c.z) * bflo(h.z); z[5] = bfhi(c.z) * bfhi(h.z); z[6] = bflo(c.w) * bflo(h.w); z[7] = bfhi(c.w) * bfhi(h.w);
            if (t0 == 0 && k < 2) {
#pragma unroll
                for (int i = 0; i < 8; ++i) z[i] = 0.f; }
            if (k >= 2) {
                const v4u b = *(const v4u*)(F.PROJ + (size_t)(t0 + k - 2) * DIN + C_B + c0); float bb[8], y[8];
                bb[0] = bflo(b.x); bb[1] = bfhi(b.x); bb[2] = bflo(b.y); bb[3] = bfhi(b.y); bb[4] = bflo(b.z); bb[5] = bfhi(b.z); bb[6] = bflo(b.w); bb[7] = bfhi(b.w);
                float ss = 0.f;
#pragma unroll
                for (int i = 0; i < 8; ++i) { y[i] = bb[i] * (w0[i] * z2[i] + w1[i] * z1[i] + w2[i] * z[i]); ss += y[i] * y[i]; }
                ss += __shfl_xor(ss, 1); ss += __shfl_xor(ss, 2); ss += __shfl_xor(ss, 4);
                const float rstd = __builtin_amdgcn_rsqf(ss * (1.f / 64.f) + EPS);
                v4u o; o.x = pk2(y[0] * rstd * go[0], y[1] * rstd * go[1]); o.y = pk2(y[2] * rstd * go[2], y[3] * rstd * go[3]); o.z = pk2(y[4] * rstd * go[4], y[5] * rstd * go[5]); o.w = pk2(y[6] * rstd * go[6], y[7] * rstd * go[7]);
                *(v4u*)(F.Y + (size_t)(t0 + k - 2) * D + c0) = o;
            }
#pragma unroll
            for (int i = 0; i < 8; ++i) { z2[i] = z1[i]; z1[i] = z[i]; }
        }
    }
}

__device__ __forceinline__ void ced(int& a, int& b) { const int hi = a > b ? a : b, lo = a > b ? b : a; a = hi; b = lo; }
template <int OFF> __device__ __forceinline__ void sort16_desc(int (&v)[64]) {
#pragma unroll
    for (int lk = 1; lk <= 4; ++lk) {
#pragma unroll
        for (int lj = lk - 1; lj >= 0; --lj) {
#pragma unroll
            for (int i = 0; i < 16; ++i) { const int k = 1 << lk, j = 1 << lj, l = i ^ j;
                if (l > i) { if ((i & k) == 0) ced(v[OFF + i], v[OFF + l]); else ced(v[OFF + l], v[OFF + i]); } }
        }
    }
}
template <int OA, int OB> __device__ __forceinline__ void merge16(int (&v)[64]) {
#pragma unroll
    for (int i = 0; i < 16; ++i) v[OA + i] = v[OA + i] > v[OB + 15 - i] ? v[OA + i] : v[OB + 15 - i];
#pragma unroll
    for (int lj = 3; lj >= 0; --lj) {
#pragma unroll
        for (int i = 0; i < 16; ++i) { const int j = 1 << lj, l = i ^ j; if (l > i) ced(v[OA + i], v[OA + l]); }
    }
}
__device__ __forceinline__ void top16_64(int (&v)[64]) {
    sort16_desc<0>(v); sort16_desc<16>(v); sort16_desc<32>(v); sort16_desc<48>(v);
    merge16<0, 16>(v); merge16<32, 48>(v); merge16<0, 32>(v);
}
__device__ __forceinline__ int f2key(float x) { const int b = __builtin_bit_cast(int, x); return b ^ ((b >> 31) & 0x7fffffff); }
__device__ __forceinline__ float key2f(int k) { return __builtin_bit_cast(float, k ^ ((k >> 31) & 0x7fffffff)); }

template <class Sched> __device__ __forceinline__ void p4b_topk(Frame& F, const Sched& S) {
    const int lane = F.lane, r = lane & 31, hh = lane >> 5, tid = F.tid;
    LAS unsigned char* keysL = F.lds;
    LAS unsigned* lut = (LAS unsigned*)(F.lds + 69632 + F.wave * 4096) + lane;
    pg8::Unit un, unn;
    bool has = S.next(0, un);
    v4u kreg[8]; bf16x8 bq[8];
    if (has) { const int row = tid >> 1, half = tid & 1; const v4u* src = (const v4u*)(F.KEYS + (size_t)(un.pn * 256 + row) * 128 + half * 64);
#pragma unroll
        for (int i = 0; i < 8; ++i) kreg[i] = src[i];
        const bf16* qn = F.Q + (size_t)(un.pm * 256 + F.wave * 32 + r) * NQ + un.pn * 256 + 8 * hh;
#pragma unroll
        for (int s = 0; s < 8; ++s) bq[s] = *(const bf16x8*)(qn + 16 * s); }
    for (int round = 0; has; ++round) {
        const int h = un.pn;
        const int t0 = un.pm * 256 + F.wave * 32;
        const bf16* qb0 = F.Q + (size_t)(t0 + r) * NQ + h * 256 + 8 * hh;
        __syncthreads();
        { const int row = tid >> 1, half = tid & 1; LAS v4u* dst = (LAS v4u*)(keysL + row * 272 + half * 128);
#pragma unroll
            for (int i = 0; i < 8; ++i) dst[i] = kreg[i]; }
        __syncthreads();
        const bool has_next = S.next(round + 1, unn);
        int v[64];
        int part0[16], part1[16];
#pragma unroll
        for (int i = 0; i < 16; ++i) { part0[i] = 0; part1[i] = 0; }
#pragma unroll 1
        for (int p = 0; p < 2; ++p) {
            f32x16 acc[4];
#pragma unroll
            for (int m = 0; m < 4; ++m)
#pragma unroll
                for (int e = 0; e < 16; ++e) acc[m][e] = 0.f;
            const LAS unsigned char* kb = keysL + (p * 128 + r) * 272 + 16 * hh;
#pragma unroll
            for (int s = 0; s < 8; ++s) {
#pragma unroll
                for (int m = 0; m < 4; ++m) { const bf16x8 a = *(const LAS bf16x8*)(kb + (32 * m) * 272 + 32 * s); acc[m] = __builtin_amdgcn_mfma_f32_32x32x16_bf16(a, bq[s], acc[m], 0, 0, 0); } }
            if (p == 0) {
#pragma unroll
                for (int s = 0; s < 8; ++s) bq[s] = *(const bf16x8*)(qb0 + 128 + 16 * s); }
#pragma unroll
            for (int m = 0; m < 4; ++m)
#pragma unroll
                for (int e = 0; e < 16; ++e) v[m * 16 + e] = (f2key(acc[m][e]) & ~127) | (32 * m + (e & 3) + 8 * (e >> 2)) | (4 * hh);
            top16_64(v);
#pragma unroll
            for (int i = 0; i < 16; ++i) { part0[i] = (p == 0) ? v[i] : part0[i]; part1[i] = (p == 0) ? part1[i] : v[i]; }
        }
        if (has_next) { const int row = tid >> 1, half = tid & 1; const v4u* src = (const v4u*)(F.KEYS + (size_t)(unn.pn * 256 + row) * 128 + half * 64);
#pragma unroll
            for (int i = 0; i < 8; ++i) kreg[i] = src[i];
            const bf16* qn = F.Q + (size_t)(unn.pm * 256 + F.wave * 32 + r) * NQ + unn.pn * 256 + 8 * hh;
#pragma unroll
            for (int s = 0; s < 8; ++s) bq[s] = *(const bf16x8*)(qn + 16 * s); }
#pragma unroll
        for (int i = 0; i < 16; ++i) { const int send = hh ? part0[i] : part1[i]; const int recv = __shfl_xor(send, 32); v[i] = hh ? part1[i] : part0[i]; v[16 + i] = recv; }
        merge16<0, 16>(v);
        int L0[16], L1[16];
#pragma unroll
        for (int i = 0; i < 16; ++i) { const int other = __shfl_xor(v[i], 32); L0[i] = hh ? other : v[i]; L1[i] = hh ? v[i] : other; }
#pragma unroll
        for (int i = 0; i < 16; ++i) lut[64 * i] = (unsigned)(L0[i] & 127) | ((unsigned)(L1[i] & 127) << 8);
        {
            float a0[16], a1[16];
#pragma unroll
            for (int i = 0; i < 16; ++i) { a0[i] = key2f(L0[i]); a1[i] = key2f(L1[i]); }
            int n = 0;
#pragma unroll
            for (int i = 0; i < 16; ++i)
#pragma unroll
                for (int j = 0; j < 16; ++j) if ((i + 1) * (j + 1) <= 16) { v[n] = (f2key(a0[i] + a1[j]) & ~255) | (i * 16 + j); ++n; }
#pragma unroll
            for (int k = 50; k < 64; ++k) v[k] = (int)0x80000000;
        }
        top16_64(v);
        float val[16], ex[16]; int eid[16]; float sum = 0.f;
#pragma unroll
        for (int k = 0; k < 16; ++k) { const int pos = v[k] & 255; const int i1 = (int)(lut[64 * (pos >> 4)] & 255u), i2 = (int)(lut[64 * (pos & 15)] >> 8); eid[k] = i1 * 128 + i2; val[k] = key2f(v[k] & ~255); }
#pragma unroll
        for (int k = 0; k < 16; ++k) { ex[k] = __expf(val[k] - val[0]); sum += ex[k]; }
        const float rs = 1.0f / sum;
        if (hh == 0) {
            v4u* ip = (v4u*)(F.IDX + (size_t)(t0 + r) * NSEL + h * 16); f32x4* gp = (f32x4*)(F.GATE + (size_t)(t0 + r) * NSEL + h * 16);
#pragma unroll
            for (int k = 0; k < 4; ++k) { ip[k] = (v4u){(unsigned)eid[4 * k], (unsigned)eid[4 * k + 1], (unsigned)eid[4 * k + 2], (unsigned)eid[4 * k + 3]};
                gp[k] = (f32x4){ex[4 * k] * rs, ex[4 * k + 1] * rs, ex[4 * k + 2] * rs, ex[4 * k + 3] * rs}; }
        }
        LDS_WAIT();
        has = has_next; un = unn;
    }
}

constexpr int P6_SL = 32, P6_SHIFT = 9, P6_ROWS = 8, P6_TOK = 8, P6_NCH = NSEL / P6_ROWS;
#ifndef P6_BAR_A
#define P6_BAR_A 1
#endif
#ifndef P6_BAR_B
#define P6_BAR_B 2
#endif
typedef _Float16 h16x2 __attribute__((ext_vector_type(2)));
__device__ __forceinline__ float gelu_fast(float v) {
    const float av = fabsf(v), t = __builtin_amdgcn_rcpf(av * 0.2316418882f + 1.0f);
    float q = t * 0.5307027145f + (-0.7265760135f); q = q * t + 0.7107068705f; q = q * t + (-0.142248368f); q = q * t + 0.127414796f; q = q * t;
    const float e = __builtin_amdgcn_exp2f((v * v) * (-0.72134752044f)); const float m = v * (q * e);
    return v < 0.f ? m : v - m;
}
__device__ __forceinline__ int p6_jmap(int lane) { return ((lane >> 5) << 2) | (((lane >> 4) & 1) << 1) | ((lane >> 3) & 1); }
__host__ __device__ constexpr int p6_lane_of(int j) { return 32 * (j >> 2) + 16 * ((j >> 1) & 1) + 8 * (j & 1); }
__device__ __forceinline__ void p6_issue(const LAS unsigned char* lstk, int first, __amdgpu_buffer_rsrc_t rs, int lane, int lane16, v4u (&rows)[P6_ROWS], v4u& ent) {
    ent = *(const LAS v4u*)(lstk + (first + p6_jmap(lane)) * 16);
    const unsigned e_x = ent.x;
#pragma unroll
    for (int j = 0; j < P6_ROWS; ++j) { const int e = __builtin_amdgcn_readlane((int)e_x, p6_lane_of(j)); rows[j] = __builtin_amdgcn_raw_buffer_load_b128(rs, lane16, e << 10, 0); }
}
__device__ __forceinline__ void p6_compute_a(LAS unsigned char* lstk, int first, const int (&hq)[4], int lane, const v4u (&uu)[P6_ROWS], const v4u& ent) {
    int d[8];
#pragma unroll
    for (int j = 0; j < 8; ++j) { const v4u u = uu[j]; int a = __builtin_amdgcn_sdot4((int)u.x, hq[0], 0, false); a = __builtin_amdgcn_sdot4((int)u.y, hq[1], a, false);
        a = __builtin_amdgcn_sdot4((int)u.z, hq[2], a, false); a = __builtin_amdgcn_sdot4((int)u.w, hq[3], a, false); d[j] = a; }
    int r1[4], r2[2];
#pragma unroll
    for (int i = 0; i < 4; ++i) { const auto q = __builtin_amdgcn_permlane32_swap((unsigned)d[i], (unsigned)d[i + 4], false, false); r1[i] = (int)(q[0] + q[1]); }
#pragma unroll
    for (int i = 0; i < 2; ++i) { const auto q = __builtin_amdgcn_permlane16_swap((unsigned)r1[i], (unsigned)r1[i + 2], false, false); r2[i] = (int)(q[0] + q[1]); }
    const bool b3 = lane & 8;
    int r3 = (b3 ? r2[1] : r2[0]) + __builtin_amdgcn_update_dpp(0, b3 ? r2[0] : r2[1], 0x128, 0xf, 0xf, false);
    r3 += __builtin_amdgcn_update_dpp(0, r3, 0xB1, 0xf, 0xf, false); r3 += __builtin_amdgcn_update_dpp(0, r3, 0x4E, 0xf, 0xf, false); r3 += __builtin_amdgcn_update_dpp(0, r3, 0x141, 0xf, 0xf, false);
    const unsigned e_y = ent.y, e_z = ent.z; const float dsv = __builtin_bit_cast(float, e_y), gsv = __builtin_bit_cast(float, e_z);
    const float cf = gsv * gelu_fast((float)r3 * dsv) * 256.0f;
    const h16x2 c2 = (h16x2){(_Float16)cf, (_Float16)cf};
    *(LAS unsigned*)(lstk + (first + p6_jmap(lane)) * 16 + 12) = __builtin_bit_cast(unsigned, c2);
}
typedef unsigned v2u __attribute__((ext_vector_type(2)));
template <int SEL> __device__ __forceinline__ h16x2 p6_cvt4(unsigned w) { const auto r = __builtin_amdgcn_cvt_scalef32_pk_f16_fp4(w, 0.00390625f, SEL); return __builtin_bit_cast(h16x2, r); }
__device__ __forceinline__ void p6_issue_b(const LAS unsigned char* lstk, int first, __amdgpu_buffer_rsrc_t rs, int lane, v2u (&rows)[P6_ROWS], v4u& ent) {
    ent = *(const LAS v4u*)(lstk + (first + p6_jmap(lane)) * 16);
    const unsigned e_x = ent.x;
#pragma unroll
    for (int j = 0; j < P6_ROWS; ++j) { const int e = __builtin_amdgcn_readlane((int)e_x, p6_lane_of(j)); rows[j] = __builtin_amdgcn_raw_buffer_load_b64(rs, lane * 8, e << 9, 0); }
}
__device__ __forceinline__ void p6_compute_b(int lane, const v2u (&vv)[P6_ROWS], const v4u& ent, h16x2 (&acc)[8]) {
    const unsigned e_w = ent.w;
#pragma unroll
    for (int j = 0; j < P6_ROWS; ++j) { const h16x2 c2 = __builtin_bit_cast(h16x2, (unsigned)__builtin_amdgcn_readlane((int)e_w, p6_lane_of(j)));
        const unsigned w0 = vv[j].x, w1 = vv[j].y;
        acc[0] = __builtin_elementwise_fma(c2, p6_cvt4<0>(w0), acc[0]); acc[1] = __builtin_elementwise_fma(c2, p6_cvt4<1>(w0), acc[1]); acc[2] = __builtin_elementwise_fma(c2, p6_cvt4<2>(w0), acc[2]); acc[3] = __builtin_elementwise_fma(c2, p6_cvt4<3>(w0), acc[3]);
        acc[4] = __builtin_elementwise_fma(c2, p6_cvt4<0>(w1), acc[4]); acc[5] = __builtin_elementwise_fma(c2, p6_cvt4<1>(w1), acc[5]); acc[6] = __builtin_elementwise_fma(c2, p6_cvt4<2>(w1), acc[6]); acc[7] = __builtin_elementwise_fma(c2, p6_cvt4<3>(w1), acc[7]); }
}
__device__ __forceinline__ void p6_peer(Frame& F) {
    const int lane = F.lane;
    LAS unsigned char* lst = F.lds + F.wave * 16384;
    const __amdgpu_buffer_rsrc_t rsU = __builtin_amdgcn_make_buffer_rsrc((void*)F.U8, 0, NEXP * D, 0x00020000), rsV = __builtin_amdgcn_make_buffer_rsrc((void*)F.V8, 0, NEXP * (D / 2), 0x00020000);
    const int lane16 = lane * 16;
    for (int tg0 = 0; tg0 < M / P6_TOK; tg0 += F.NGW) {
    const int tb = ((tg0 + F.gw < M / P6_TOK) ? tg0 + F.gw : M / P6_TOK - 1) * P6_TOK;
    int hq[P6_TOK][4];
    {
        v4u hb[P6_TOK][2]; int ia[P6_TOK], ib[P6_TOK]; float gta[P6_TOK], gtb[P6_TOK], ssq[P6_TOK];
#pragma unroll
        for (int k = 0; k < P6_TOK; ++k) {
            const int t = tb + k;
            const v4u* hp = (const v4u*)(F.HB + (size_t)t * D) + 2 * lane; hb[k][0] = hp[0]; hb[k][1] = hp[1];
            ia[k] = F.IDX[(size_t)t * NSEL + lane]; ib[k] = F.IDX[(size_t)t * NSEL + 64 + lane];
            gta[k] = F.GATE[(size_t)t * NSEL + lane]; gtb[k] = F.GATE[(size_t)t * NSEL + 64 + lane]; ssq[k] = F.sumsq[t];
        }
        f32x4 g4[4];
#pragma unroll
        for (int i = 0; i < 4; ++i) g4[i] = ((const f32x4*)F.ffn_g + 4 * lane)[i];
        float sua[P6_TOK], sub[P6_TOK], sva[P6_TOK], svb[P6_TOK];
#pragma unroll
        for (int k = 0; k < P6_TOK; ++k) { sua[k] = F.SU[ia[k]]; sub[k] = F.SU[ib[k]]; sva[k] = F.SV[ia[k]]; svb[k] = F.SV[ib[k]]; }
#pragma unroll
        for (int k = 0; k < P6_TOK; ++k) {
            const unsigned hw[8] = {hb[k][0].x, hb[k][0].y, hb[k][0].z, hb[k][0].w, hb[k][1].x, hb[k][1].y, hb[k][1].z, hb[k][1].w};
            float hf[16]; float amax = 0.f;
#pragma unroll
            for (int i = 0; i < 4; ++i) { hf[4 * i] = bflo(hw[2 * i]) * g4[i][0]; hf[4 * i + 1] = bfhi(hw[2 * i]) * g4[i][1]; hf[4 * i + 2] = bflo(hw[2 * i + 1]) * g4[i][2]; hf[4 * i + 3] = bfhi(hw[2 * i + 1]) * g4[i][3]; }
#pragma unroll
            for (int i = 0; i < 16; ++i) amax = fmaxf(amax, fabsf(hf[i]));
#pragma unroll
            for (int o = 1; o < 64; o <<= 1) amax = fmaxf(amax, __shfl_xor(amax, o));
            const float hsc = amax > 0.f ? 127.f / amax : 1.f, hinv = amax > 0.f ? amax * (1.f / 127.f) : 1.f;
#pragma unroll
            for (int i = 0; i < 4; ++i) hq[k][i] = (int)pack_i8(hf[4 * i] * hsc, hf[4 * i + 1] * hsc, hf[4 * i + 2] * hsc, hf[4 * i + 3] * hsc);
            const float inv = __builtin_amdgcn_rsqf(ssq[k] * (1.f / D) + EPS) * hinv;
            const float da = inv * sua[k], db = inv * sub[k];
            const float ga = gta[k] * sva[k], gb = gtb[k] * svb[k];
            const int sa = ia[k] >> P6_SHIFT, sb = ib[k] >> P6_SHIFT;
            LAS unsigned* hist = (LAS unsigned*)(lst + k * 2048);
            if (lane < P6_SL) hist[lane] = 0u;
            const unsigned rka = __hip_atomic_fetch_add(hist + sa, 1u, __ATOMIC_RELAXED, __HIP_MEMORY_SCOPE_WORKGROUP);
            const unsigned rkb = __hip_atomic_fetch_add(hist + sb, 1u, __ATOMIC_RELAXED, __HIP_MEMORY_SCOPE_WORKGROUP);
            unsigned cnt = (lane < P6_SL) ? hist[lane] : 0u, inc = cnt;
#pragma unroll
            for (int o = 1; o < P6_SL; o <<= 1) { const unsigned up = __shfl_up(inc, o); inc += (lane >= o) ? up : 0u; }
            if (lane < P6_SL) hist[P6_SL + lane] = inc - cnt;
            const int pa = (int)(hist[P6_SL + sa] + rka), pb = (int)(hist[P6_SL + sb] + rkb);
            LDS_WAIT();
            *(LAS v4u*)(lst + k * 2048 + pa * 16) = (v4u){(unsigned)ia[k], __builtin_bit_cast(unsigned, da), __builtin_bit_cast(unsigned, ga), 0u};
            *(LAS v4u*)(lst + k * 2048 + pb * 16) = (v4u){(unsigned)ib[k], __builtin_bit_cast(unsigned, db), __builtin_bit_cast(unsigned, gb), 0u};
        }
    }
    v4u r0[P6_ROWS], r1[P6_ROWS]; v4u e0, e1;
#define P6_ISSUE(SET, kk, cc, RS) p6_issue(lst + (kk) * 2048, (cc) * P6_ROWS, RS, lane, lane16, r##SET, e##SET)
#define P6_CA(SET, kk, cc) p6_compute_a(lst + (kk) * 2048, (cc) * P6_ROWS, hq[kk], lane, r##SET, e##SET)
    P6_ISSUE(0, 0, 0, rsU);
    for (int c = 0; c < P6_NCH; ++c) {
        if (P6_BAR_A && (c % (P6_BAR_A ? P6_BAR_A : 1)) == 0) __builtin_amdgcn_s_barrier();
        const int cn = (c + 1 < P6_NCH) ? c + 1 : c;
        P6_ISSUE(1, 1, c, rsU); P6_CA(0, 0, c);  P6_ISSUE(0, 2, c, rsU); P6_CA(1, 1, c);  P6_ISSUE(1, 3, c, rsU); P6_CA(0, 2, c);  P6_ISSUE(0, 4, c, rsU); P6_CA(1, 3, c);
        P6_ISSUE(1, 5, c, rsU); P6_CA(0, 4, c);  P6_ISSUE(0, 6, c, rsU); P6_CA(1, 5, c);  P6_ISSUE(1, 7, c, rsU); P6_CA(0, 6, c);  P6_ISSUE(0, 0, cn, rsU); P6_CA(1, 7, c);
    }
#undef P6_CA
    h16x2 acc[P6_TOK][8];
#pragma unroll
    for (int k = 0; k < P6_TOK; ++k)
#pragma unroll
        for (int i = 0; i < 8; ++i) acc[k][i] = (h16x2){(_Float16)0.f, (_Float16)0.f};
    v2u q0[P6_ROWS], q1[P6_ROWS];
#define P6_ISSUE_B(SET, kk, cc) p6_issue_b(lst + (kk) * 2048, (cc) * P6_ROWS, rsV, lane, q##SET, e##SET)
#define P6_CB(SET, kk) p6_compute_b(lane, q##SET, e##SET, acc[kk])
    P6_ISSUE_B(0, 0, 0);
    for (int c = 0; c < P6_NCH; ++c) {
        if (P6_BAR_B && (c % (P6_BAR_B ? P6_BAR_B : 1)) == 0) __builtin_amdgcn_s_barrier();
        const int cn = (c + 1 < P6_NCH) ? c + 1 : c;
        P6_ISSUE_B(1, 1, c); P6_CB(0, 0);  P6_ISSUE_B(0, 2, c); P6_CB(1, 1);  P6_ISSUE_B(1, 3, c); P6_CB(0, 2);  P6_ISSUE_B(0, 4, c); P6_CB(1, 3);
        P6_ISSUE_B(1, 5, c); P6_CB(0, 4);  P6_ISSUE_B(0, 6, c); P6_CB(1, 5);  P6_ISSUE_B(1, 7, c); P6_CB(0, 6);  P6_ISSUE_B(0, 0, cn); P6_CB(1, 7);
    }
#undef P6_CB
#undef P6_ISSUE_B
#undef P6_ISSUE
    v4u hbt[P6_TOK][2];
#pragma unroll
    for (int k = 0; k < P6_TOK; ++k) { const v4u* hbp = (const v4u*)(F.HB + (size_t)(tb + k) * D) + 2 * lane; hbt[k][0] = hbp[0]; hbt[k][1] = hbp[1]; }
    f32x4 fg[4];
#pragma unroll
    for (int i = 0; i < 4; ++i) fg[i] = ((const f32x4*)F.final_g + 4 * lane)[i];
#pragma unroll
    for (int k = 0; k < P6_TOK; ++k) {
        const int t = tb + k;
        const unsigned hww[8] = {hbt[k][0].x, hbt[k][0].y, hbt[k][0].z, hbt[k][0].w, hbt[k][1].x, hbt[k][1].y, hbt[k][1].z, hbt[k][1].w};
        f32x4* orow = (f32x4*)(F.out + (size_t)t * D) + 4 * lane;
        f32x4 hv[4]; float ss = 0.f;
#pragma unroll
        for (int i = 0; i < 4; ++i) { hv[i][0] = bflo(hww[2 * i]) + (float)acc[k][2 * i].x; hv[i][1] = bfhi(hww[2 * i]) + (float)acc[k][2 * i].y; hv[i][2] = bflo(hww[2 * i + 1]) + (float)acc[k][2 * i + 1].x; hv[i][3] = bfhi(hww[2 * i + 1]) + (float)acc[k][2 * i + 1].y;
            ss += (hv[i][0] * hv[i][0] + hv[i][1] * hv[i][1]) + (hv[i][2] * hv[i][2] + hv[i][3] * hv[i][3]); }
        float rstd = __builtin_amdgcn_rsqf(wave_sum(ss) * (1.f / D) + EPS);
#pragma unroll
        for (int i = 0; i < 4; ++i) orow[i] = hv[i] * rstd * fg[i];
    }
    }
}

constexpr int N_PHASES = 7;
struct Args { const float* in[16]; float* out; unsigned char* ws; int ph_lo, ph_hi; };
static_assert(sizeof(Args) == 16 * 8 + 8 + 8 + 8, "Args has no padding");
__global__ void __launch_bounds__(NWAVES * 64, 2) fwd_kernel(Args args) {
    extern __shared__ __attribute__((aligned(16))) unsigned char lds[];
    Frame F;
    F.lds = (LAS unsigned char*)lds;
    F.MISC = (volatile LAS unsigned*)(F.lds + MISC_OFF);
    F.tid = threadIdx.x; F.lane = F.tid & 63; F.wave = __builtin_amdgcn_readfirstlane(F.tid >> 6);
    F.G = gridDim.x; { const int bx = blockIdx.x; F.vcu = (F.G % 8 == 0) ? (bx % 8) * (F.G / 8) + bx / 8 : bx; }
    F.gw = F.vcu * NWAVES + F.wave; F.NGW = F.G * NWAVES;
    frame_ptrs(F, args.in, args.out, args.ws);
    for (int u = F.tid; u < (LDS_BYTES - LDSCTL_OFF) / 4; u += NWAVES * 64) ((LAS unsigned*)(F.lds + LDSCTL_OFF))[u] = 0u;
    __syncthreads();
    const int lo = args.ph_lo, hi = args.ph_hi;
    const bool use_bar = (hi - lo) > 1;
    XcdBarrier bar; bar.bar = (unsigned*)(F.ctl + CW_BAR); bar.x = 0; bar.st = nullptr;
    if (use_bar) bar = xcd_barrier_post((unsigned*)(F.ctl + CW_BAR), F.MISC + 8);
#define IN(k) (lo <= (k) && (k) < hi)
#define SEAM(k) do { if (IN(k) && IN((k) + 1)) xcd_barrier(bar); } while (0)
    if (IN(0)) { p0_prologue(F); SEAM(0); }
    if (IN(1)) {
        pg8::Gemm g{F.XN, F.WinT, M, DIN, D}; pg8::StaticOrder S; S.init(M, DIN, F.G, (int)blockIdx.x);
        pg8::EpiProj E{F.PROJ, DIN, C_U / 256};
        pg8::gemm_phase<pg8::EpiProj, pg8::StaticOrder, true, true>(F.lds, g, S, E);
        { const int nwg = (M / 256) * (DIN / 256), rem = nwg % F.G;
          const int first = rem ? rem : 0, nconv = F.G - first;
          if ((int)blockIdx.x >= first) late_weights(F, ((int)blockIdx.x - first) * NWAVES + F.wave, nconv * NWAVES); }
        SEAM(1);
    }
    if (IN(2)) { p2_mixer(F); SEAM(2); }
    if (IN(3)) {
        pg8::Gemm g{F.Y, F.WoutT, M, D, D}; pg8::StaticOrder S; S.init(M, D, F.G, (int)blockIdx.x);
        pg8::EpiH E{F.x, F.HB, F.sumsq, D};
        pg8::gemm_phase<pg8::EpiH, pg8::StaticOrder, true, true>(F.lds, g, S, E);
        SEAM(3);
    }
    if (IN(4)) {
        pg8::Gemm g{F.HB, F.WqT, M, NQ, D}; pg8::StaticOrder S; S.init(M, NQ, F.G, (int)blockIdx.x);
        pg8::EpiQ E{F.Q, NQ, F.sumsq, 1.f / D, EPS};
        pg8::gemm_phase<pg8::EpiQ, pg8::StaticOrder, true, true>(F.lds, g, S, E);
        VM_WAIT(); __syncthreads();
        p4b_topk(F, S);
        convert_tables(F, F.gw, F.NGW, 0, 2 * NEXP);
        SEAM(5);
    }
    if (IN(6)) p6_peer(F);
#undef IN
#undef SEAM
}

#ifndef NV_P1
#define NV_P1 (MK_MODE == 0)
#endif
#ifndef NV_P2
#define NV_P2 (MK_MODE == 0)
#endif
#ifndef NV_P3
#define NV_P3 (MK_MODE == 0)
#endif
#ifndef NV_P4
#define NV_P4 (MK_MODE == 0)
#endif
#ifndef NV_P5
#define NV_P5 (MK_MODE == 0)
#endif
#ifndef NV_P6
#define NV_P6 (MK_MODE == 0)
#endif
#define NV_ANY (NV_P1 || NV_P2 || NV_P3 || NV_P4 || NV_P5 || NV_P6)
#if NV_ANY
template <class Epi> __global__ void __launch_bounds__(256) nv_gemm(const bf16* A, const bf16* Bt, int K, Epi E) {
    __shared__ float As[16][65], Bs[16][65];
    const int tx = threadIdx.x & 15, ty = threadIdx.x >> 4, m0 = blockIdx.y * 64, n0 = blockIdx.x * 64;
    float acc[4][4];
#pragma unroll
    for (int i = 0; i < 4; ++i)
#pragma unroll
        for (int j = 0; j < 4; ++j) acc[i][j] = 0.f;
    for (int k0 = 0; k0 < K; k0 += 16) {
        for (int i = threadIdx.x; i < 1024; i += 256) { const int r = i >> 4, c = i & 15; As[c][r] = bf2f(A[(size_t)(m0 + r) * K + k0 + c]); Bs[c][r] = bf2f(Bt[(size_t)(n0 + r) * K + k0 + c]); }
        __syncthreads();
#pragma unroll
        for (int kk = 0; kk < 16; ++kk)
#pragma unroll
            for (int i = 0; i < 4; ++i)
#pragma unroll
                for (int j = 0; j < 4; ++j) acc[i][j] += As[kk][ty * 4 + i] * Bs[kk][tx * 4 + j];
        __syncthreads();
    }
#pragma unroll
    for (int i = 0; i < 4; ++i)
#pragma unroll
        for (int j = 0; j < 4; ++j) E(m0 + ty * 4 + i, n0 + tx * 4 + j, acc[i][j]);
}
struct NvEpiProj { bf16* O; __device__ void operator()(int r, int c, float v) const { O[(size_t)r * DIN + c] = (bf16)f2bf(c >= C_U ? gelu_exact(v) : v); } };
struct NvEpiH { const float* X; float* H; bf16* HB; __device__ void operator()(int r, int c, float v) const { const float h = X[(size_t)r * D + c] + v; H[(size_t)r * D + c] = h; HB[(size_t)r * D + c] = (bf16)f2bf(h); } };
struct NvEpiQ { bf16* O; const float* sumsq; __device__ void operator()(int r, int c, float v) const { O[(size_t)r * NQ + c] = (bf16)f2bf(v * (1.0f / sqrtf(sumsq[r] * (1.f / D) + EPS))); } };
__global__ void __launch_bounds__(256) nv_rowss(const float* H, float* sumsq) {
    const int row = blockIdx.x * 4 + (threadIdx.x >> 6), lane = threadIdx.x & 63; float s = 0.f;
    for (int c = lane; c < D; c += 64) { const float h = H[(size_t)row * D + c]; s += h * h; }
    s = wave_sum(s); if (lane == 0) sumsq[row] = s;
}
__global__ void __launch_bounds__(256) nv_mix1(const bf16* PROJ, const float* gv, float* VN) {
    const int t = blockIdx.x, c = threadIdx.x * 2; const float a = bf2f(PROJ[(size_t)t * DIN + C_V + c]), b = bf2f(PROJ[(size_t)t * DIN + C_V + c + 1]);
    float ss = a * a + b * b;
    ss = wave_sum(ss);
    const float rstd = 1.0f / sqrtf(ss * (1.f / 128.f) + EPS);
    VN[(size_t)t * SW + c] = a * rstd * gv[c]; VN[(size_t)t * SW + c + 1] = b * rstd * gv[c + 1];
}
__global__ void __launch_bounds__(256) nv_mix2(const bf16* PROJ, const float* VN, const float* conv_w, const float* sgu_w, const float* sgu_b, float* YP) {
    const int t = blockIdx.x, tid = threadIdx.x;
    for (int c = tid; c < D; c += 256) {
        float y;
        if (c < CW) {
            float conv = 0.f;
            for (int k = 0; k < 3; ++k) { const int ts = t - 2 + k; if (ts >= 0) conv += conv_w[k * CW + c] * (bf2f(PROJ[(size_t)ts * DIN + C_C + c]) * bf2f(PROJ[(size_t)ts * DIN + C_H + c])); }
            y = bf2f(PROJ[(size_t)t * DIN + C_B + c]) * conv;
        } else {
            const int cc = c - CW, g = cc >> 7, i = t & 127, nb = t >> 7; float mix = sgu_b[g * 128 + i];
            for (int j = 0; j < 128; ++j) if ((i >> 6) >= (j >> 6)) mix += sgu_w[(size_t)(g * 128 + i) * 128 + j] * VN[(size_t)(nb * 128 + j) * SW + cc];
            y = bf2f(PROJ[(size_t)t * DIN + C_U + cc]) * mix;
        }
        YP[(size_t)t * D + c] = y;
    }
}
__global__ void __launch_bounds__(256) nv_mix3(const float* YP, const float* gc, const float* gs, bf16* Y) {
    const int t = blockIdx.x, c = threadIdx.x * 4; float v[4], ss = 0.f;
#pragma unroll
    for (int i = 0; i < 4; ++i) { v[i] = YP[(size_t)t * D + c + i]; ss += v[i] * v[i]; }
    ss += __shfl_xor(ss, 1); ss += __shfl_xor(ss, 2); ss += __shfl_xor(ss, 4); ss += __shfl_xor(ss, 8);
    float n = 64.f; if (c >= CW) { ss += __shfl_xor(ss, 16); n = 128.f; }
    const float rstd = 1.0f / sqrtf(ss / n + EPS);
#pragma unroll
    for (int i = 0; i < 4; ++i) { const float g = c < CW ? gc[c + i] : gs[c - CW + i]; Y[(size_t)t * D + c + i] = (bf16)f2bf(v[i] * rstd * g); }
}
__global__ void __launch_bounds__(64) nv_topk(const bf16* Q, const bf16* KEYS, int* IDX, float* GATE) {
    __shared__ float sc[32][257]; __shared__ float tv[32][2][16]; __shared__ int ti[32][2][16]; __shared__ unsigned char used[32][256];
    const int tid = threadIdx.x; if (tid >= 32) return;
    const int h = blockIdx.x & 7, t = (blockIdx.x >> 3) * 32 + tid;
    for (int p = 0; p < 2; ++p) for (int k = 0; k < 128; ++k) { float s = 0.f;
        for (int d = 0; d < 128; ++d) s += bf2f(Q[(size_t)t * NQ + h * 256 + p * 128 + d]) * bf2f(KEYS[(size_t)((h * 2 + p) * 128 + k) * 128 + d]);
        sc[tid][p * 128 + k] = s; }
    for (int p = 0; p < 2; ++p) for (int n = 0; n < 16; ++n) { float best = -3.0e38f; int bi = 0;
        for (int k = 0; k < 128; ++k) { const float s = sc[tid][p * 128 + k]; if (s > best) { best = s; bi = k; } }
        tv[tid][p][n] = best; ti[tid][p][n] = bi; sc[tid][p * 128 + bi] = -3.0e38f; }
    for (int k = 0; k < 256; ++k) used[tid][k] = 0;
    float mx = -3.0e38f, sum = 0.f;
    for (int n = 0; n < 16; ++n) { float best = -3.0e38f; int bi = 0;
        for (int k = 0; k < 256; ++k) { if (used[tid][k]) continue; const float s = tv[tid][0][k >> 4] + tv[tid][1][k & 15]; if (s > best) { best = s; bi = k; } }
        used[tid][bi] = 1; sc[tid][n] = best; IDX[(size_t)t * NSEL + h * 16 + n] = ti[tid][0][bi >> 4] * 128 + ti[tid][1][bi & 15]; if (best > mx) mx = best; }
    for (int n = 0; n < 16; ++n) { const float e = expf(sc[tid][n] - mx); sc[tid][16 + n] = e; sum += e; }
    for (int n = 0; n < 16; ++n) GATE[(size_t)t * NSEL + h * 16 + n] = sc[tid][16 + n] / sum;
}
__device__ __forceinline__ float fp8f(unsigned char b) { return __builtin_amdgcn_cvt_f32_fp8((int)b, 0); }
__global__ void __launch_bounds__(256) nv_peer(const bf16* HB, const float* sumsq, const int* IDX, const float* GATE, const unsigned char* U8, const unsigned char* V8, const float* SU, const float* SV, const float* gf, const float* fg, float* H) {
    __shared__ float hn[D]; __shared__ float coef[NSEL]; __shared__ float red[4];
    const int t = blockIdx.x, tid = threadIdx.x, lane = tid & 63, w = tid >> 6;
    const float inv = 1.0f / sqrtf(sumsq[t] * (1.f / D) + EPS);
    for (int c = tid; c < D; c += 256) hn[c] = bf2f(HB[(size_t)t * D + c]) * gf[c] * inv;
    __syncthreads();
    for (int e = w; e < NSEL; e += 4) { const int id = IDX[(size_t)t * NSEL + e]; float d = 0.f;
        for (int c = lane; c < D; c += 64) d += (float)(signed char)U8[(size_t)id * D + c] * hn[c];
        d = wave_sum(d); if (lane == 0) coef[e] = GATE[(size_t)t * NSEL + e] * gelu_exact(d * SU[id]) * SV[id]; }
    __syncthreads();
    float o[4]; float ss = 0.f;
#pragma unroll
    for (int i = 0; i < 4; ++i) { const int c = tid + 256 * i; float a = 0.f; for (int e = 0; e < NSEL; ++e) a += coef[e] * fp8f(V8[(size_t)IDX[(size_t)t * NSEL + e] * D + c]); o[i] = H[(size_t)t * D + c] + a; ss += o[i] * o[i]; }
    ss = wave_sum(ss); if (lane == 0) red[w] = ss;
    __syncthreads();
    const float rstd = 1.0f / sqrtf((red[0] + red[1] + red[2] + red[3]) * (1.f / D) + EPS);
#pragma unroll
    for (int i = 0; i < 4; ++i) { const int c = tid + 256 * i; H[(size_t)t * D + c] = o[i] * rstd * fg[c]; }
}
#endif

static void launch_phases(const Args& base, int lo, int hi, int grid, hipStream_t stream) {
    Args a = base; a.ph_lo = lo; a.ph_hi = hi;
    hipLaunchKernelGGL(fwd_kernel, dim3(grid), dim3(NWAVES * 64), LDS_BYTES, stream, a);
    const hipError_t le = hipPeekAtLastError();
    if (le != hipSuccess) fprintf(stderr, "kernel_launch: launch of phases [%d,%d) failed: %s\n", lo, hi, hipGetErrorName(le));
}
extern "C" void kernel_launch(void* const* d_in, const int* in_sizes, int n_in, void* d_out, int out_size, void* d_ws, size_t ws_size, hipStream_t stream) {
    static int grid = 0;
    if (grid == 0) {
        if (n_in != 16 || in_sizes[0] != M * D || out_size != M * D || ws_size < WS_END) { fprintf(stderr, "kernel_launch: unexpected shapes (n_in %d, in0 %d, out %d, ws %zu); nothing launched\n", n_in, n_in > 0 ? in_sizes[0] : -1, out_size, ws_size); grid = -1; return; }
        int dev = 0, cus = 0, per_cu = 0;
        if (hipGetDevice(&dev) != hipSuccess || hipDeviceGetAttribute(&cus, hipDeviceAttributeMultiprocessorCount, dev) != hipSuccess) { fprintf(stderr, "kernel_launch: device query failed\n"); grid = -1; return; }
        if (hipFuncSetAttribute((const void*)fwd_kernel, hipFuncAttributeMaxDynamicSharedMemorySize, LDS_BYTES) != hipSuccess) { fprintf(stderr, "kernel_launch: hipFuncSetAttribute failed\n"); grid = -1; return; }
        if (hipOccupancyMaxActiveBlocksPerMultiprocessor(&per_cu, (const void*)fwd_kernel, NWAVES * 64, LDS_BYTES) != hipSuccess || per_cu < 1) { fprintf(stderr, "kernel_launch: occupancy query reports %d workgroups per CU; nothing launched\n", per_cu); (void)hipGetLastError(); grid = -1; return; }
        grid = cus;
        if (grid % 8 != 0 || grid > 256) grid = (grid > 256) ? 256 : (grid / 8) * 8;
        if (grid < 8) { fprintf(stderr, "kernel_launch: too few CUs (%d)\n", cus); grid = -1; return; }
    }
    if (grid < 0) return;
    if (hipMemsetAsync((char*)d_ws + WS_CTL, 0, CTL_ZERO_BYTES, stream) != hipSuccess) { fprintf(stderr, "kernel_launch: hipMemsetAsync failed\n"); return; }
    Args a{};
    for (int i = 0; i < 16; ++i) a.in[i] = (const float*)d_in[i];
    a.out = (float*)d_out; a.ws = (unsigned char*)d_ws;
#if MK_MODE == 2
    launch_phases(a, 0, N_PHASES, grid, stream);
#else
    unsigned char* ws = (unsigned char*)d_ws; float* out = (float*)d_out;
    bf16 *WinT = (bf16*)(ws + WS_WIN), *WoutT = (bf16*)(ws + WS_WOUT), *WqT = (bf16*)(ws + WS_WQ), *KEYS = (bf16*)(ws + WS_KEYS); unsigned char *U8 = ws + WS_U8, *V8 = ws + WS_V8; float *SU = (float*)(ws + WS_SU), *SV = (float*)(ws + WS_SV);
    bf16 *XN = (bf16*)(ws + WS_XN), *Y = (bf16*)(ws + WS_Y), *PROJ = (bf16*)(ws + WS_PROJ), *Q = (bf16*)(ws + WS_Q), *HB = (bf16*)(ws + WS_HB);
    int* IDX = (int*)(ws + WS_IDX); float* GATE = (float*)(ws + WS_GATE); float* sumsq = (float*)(ws + WS_CTL) + CW_SUMSQ;
    (void)WinT; (void)WoutT; (void)WqT; (void)KEYS; (void)U8; (void)V8; (void)SU; (void)SV; (void)XN; (void)Y; (void)PROJ; (void)Q; (void)HB; (void)IDX; (void)GATE; (void)sumsq; (void)out;
    launch_phases(a, 0, 1, grid, stream);
#if NV_P1
    hipLaunchKernelGGL(nv_gemm<NvEpiProj>, dim3(DIN / 64, M / 64), dim3(256), 0, stream, (const bf16*)XN, (const bf16*)WinT, D, NvEpiProj{PROJ});
    launch_phases(a, 1, 2, grid, stream);
#else
    launch_phases(a, 1, 2, grid, stream);
#endif
#if NV_P2
    { float* VN = (float*)(ws + WS_HB);
      hipLaunchKernelGGL(nv_mix1, dim3(M), dim3(256), 0, stream, (const bf16*)PROJ, a.in[6], VN);
      hipLaunchKernelGGL(nv_mix2, dim3(M), dim3(256), 0, stream, (const bf16*)PROJ, (const float*)VN, a.in[3], a.in[4], a.in[5], out);
      hipLaunchKernelGGL(nv_mix3, dim3(M), dim3(256), 0, stream, (const float*)out, a.in[7], a.in[8], Y); }
#else
    launch_phases(a, 2, 3, grid, stream);
#endif
#if NV_P3
    hipLaunchKernelGGL(nv_gemm<NvEpiH>, dim3(D / 64, M / 64), dim3(256), 0, stream, (const bf16*)Y, (const bf16*)WoutT, D, NvEpiH{a.in[0], out, HB});
    hipLaunchKernelGGL(nv_rowss, dim3(M / 4), dim3(256), 0, stream, (const float*)out, sumsq);
#else
    launch_phases(a, 3, 4, grid, stream);
#endif
#if NV_P4
    hipLaunchKernelGGL(nv_gemm<NvEpiQ>, dim3(NQ / 64, M / 64), dim3(256), 0, stream, (const bf16*)HB, (const bf16*)WqT, D, NvEpiQ{Q, sumsq});
    launch_phases(a, 4, 5, grid, stream);
#else
    launch_phases(a, 4, 5, grid, stream);
#endif
#if NV_P5
    hipLaunchKernelGGL(nv_topk, dim3((M / 32) * NH), dim3(64), 0, stream, (const bf16*)Q, (const bf16*)KEYS, IDX, GATE);
#else
    launch_phases(a, 5, 6, grid, stream);
#endif
#if NV_P6
    hipLaunchKernelGGL(nv_peer, dim3(M), dim3(256), 0, stream, (const bf16*)HB, (const float*)sumsq, (const int*)IDX, (const float*)GATE, (const unsigned char*)U8, (const unsigned char*)V8, (const float*)SU, (const float*)SV, a.in[10], a.in[15], out);
#else
    launch_phases(a, 6, 7, grid, stream);
#endif
#endif
}
```
